# Optimizing an MI355X kernel written in HIP

```python
import jax, jax.numpy as jnp
from jax import lax
import numpy as np

D_MODEL = 1024
BATCH = 32
SEQ = 2048
DEPTH = 2

CTX_LEN = 256
GRID_W = 64
RET_HEADS = 8
RET_DK = 128
RET_DV = 256
RET_QK = RET_HEADS * RET_DK
RET_V = RET_HEADS * RET_DV
CONV_WIDTH = D_MODEL
CONV_K = 3
N_BRANCH = 2
CHUNK = 128
D_FF = 256 * (-(-(8 * D_MODEL) // (3 * 256)))
ROPE_THETA = 10000.0
EPS = 1e-6
IN_COLS = 2 * RET_QK + 2 * RET_V + 3 * CONV_WIDTH + N_BRANCH * D_MODEL
IN_SPLITS = (RET_QK, 2 * RET_QK, 2 * RET_QK + RET_V, 2 * RET_QK + 2 * RET_V,
             2 * RET_QK + 2 * RET_V + CONV_WIDTH, 2 * RET_QK + 2 * RET_V + 2 * CONV_WIDTH,
             2 * RET_QK + 2 * RET_V + 3 * CONV_WIDTH)

kernel_name = 'hybrid_retention_shortconv_dit_block'


def rms_norm(x, w):
    xf = x.astype(jnp.float32)
    y = xf * lax.rsqrt(jnp.mean(xf * xf, axis=-1, keepdims=True) + EPS)
    return (y * w.astype(jnp.float32)).astype(x.dtype)


def modulation(cvec, w, b):
    m = jax.nn.silu(cvec) @ w + b
    return m.reshape(m.shape[:-1] + (6, D_MODEL))


def modulate(h, shift, scale):
    return h * (1.0 + scale) + shift


def _rotate(x, pos):
    d = x.shape[-1]
    freqs = ROPE_THETA ** (-jnp.arange(0, d, 2, dtype=jnp.float32) / d)
    ang = pos.astype(jnp.float32)[:, None] * freqs[None, :]
    cos = jnp.cos(ang)[:, None, :]
    sin = jnp.sin(ang)[:, None, :]
    xf = x.astype(jnp.float32)
    x1, x2 = xf[..., : d // 2], xf[..., d // 2:]
    return jnp.concatenate([x1 * cos - x2 * sin, x1 * sin + x2 * cos], axis=-1).astype(x.dtype)


def rope_2d(x, rows, cols):
    h = x.shape[-1] // 2
    return jnp.concatenate([_rotate(x[..., :h], rows), _rotate(x[..., h:], cols)], axis=-1)


def retention_chunkwise(q, k, v, log_g, s0):
    bsz, t, h, dk = q.shape
    dv = v.shape[-1]
    n = t // CHUNK
    idx = jnp.arange(CHUNK, dtype=jnp.float32)
    diff = idx[:, None] - idx[None, :]
    intra = jnp.exp(jnp.where(diff[None] >= 0, diff[None] * log_g[:, None, None], -jnp.inf))
    q_dec = jnp.exp((idx[:, None] + 1.0) * log_g[None, :])
    k_dec = jnp.exp((CHUNK - 1.0 - idx)[:, None] * log_g[None, :])
    chunk_dec = jnp.exp(CHUNK * log_g)

    def to_chunks(a):
        a = a.astype(jnp.float32).reshape(bsz, n, CHUNK, h, a.shape[-1])
        return jnp.moveaxis(a, 1, 0)

    def step(s, xs):
        qc, kc, vc = xs
        scores = jnp.einsum('bihd,bjhd->bhij', qc, kc) * intra
        o = jnp.einsum('bhij,bjhv->bihv', scores, vc)
        o = o + jnp.einsum('bihd,bhdv->bihv', qc, s) * q_dec[None, :, :, None]
        s = s * chunk_dec[None, :, None, None] + jnp.einsum(
            'bjhd,bjhv->bhdv', kc * k_dec[None, :, :, None], vc)
        return s, o

    s_final, o = lax.scan(step, s0.astype(jnp.float32), (to_chunks(q), to_chunks(k), to_chunks(v)))
    o = jnp.moveaxis(o, 0, 1).reshape(bsz, t, h, dv)
    return o, s_final


def bidir_retention(q, k, v, log_g, s0_fwd, s0_bwd):
    o_f, s_f = retention_chunkwise(q, k, v, log_g[0], s0_fwd)
    o_b, s_b = retention_chunkwise(q[:, ::-1], k[:, ::-1], v[:, ::-1], log_g[1], s0_bwd)
    return o_f + o_b[:, ::-1], s_f, s_b


def retention_final_states(k, v, log_g):
    t = k.shape[1]
    pos = jnp.arange(t, dtype=jnp.float32)
    w_f = jnp.exp((t - 1.0 - pos)[:, None] * log_g[0][None, :])
    w_b = jnp.exp(pos[:, None] * log_g[1][None, :])
    kf = k.astype(jnp.float32)
    vf = v.astype(jnp.float32)
    s_f = jnp.einsum('bthd,bthv->bhdv', kf * w_f[None, :, :, None], vf)
    s_b = jnp.einsum('bthd,bthv->bhdv', kf * w_b[None, :, :, None], vf)
    return s_f, s_b


def head_group_norm(o):
    mu = jnp.mean(o, axis=-1, keepdims=True)
    var = jnp.mean(jnp.square(o - mu), axis=-1, keepdims=True)
    return (o - mu) * lax.rsqrt(var + EPS)


def short_conv(u, w):
    t = u.shape[1]
    pad = CONV_K // 2
    up = jnp.pad(u, ((0, 0), (pad, pad), (0, 0)))
    out = up[:, 0:t] * w[0]
    for j in range(1, CONV_K):
        out = out + up[:, j:j + t] * w[j]
    return out


def merge_branches(o_ret, g, cb, cc, cu, gates, conv_w, w_ret_out, w_conv_out, w_o):
    bsz, t = g.shape[:2]
    y_ret = (head_group_norm(o_ret).reshape(bsz, t, RET_V).astype(g.dtype) * jax.nn.silu(g)) @ w_ret_out
    y_conv = (cb * short_conv(cc * cu, conv_w)) @ w_conv_out
    gr, gc = jnp.split(jax.nn.sigmoid(gates), 2, axis=-1)
    return (gr * y_ret + gc * y_conv) @ w_o


def hybrid_mixer(h_lat, h_ctx, w_in, decay_logit, conv_w, w_ret_out, w_conv_out, w_o, rows, cols, ctx_out):
    log_g = jax.nn.log_sigmoid(decay_logit.astype(jnp.float32))
    bsz, t_ctx = h_ctx.shape[:2]
    k_scale = RET_DK ** -0.5
    if ctx_out:
        q_c, k_c, v_c, g_c, b_c, c_c, u_c, gate_c = jnp.split(h_ctx @ w_in, IN_SPLITS, axis=-1)
        q_c = q_c.reshape(bsz, t_ctx, RET_HEADS, RET_DK)
        k_c = k_c.reshape(bsz, t_ctx, RET_HEADS, RET_DK) * k_scale
        v_c = v_c.reshape(bsz, t_ctx, RET_HEADS, RET_DV)
        s0 = jnp.zeros((bsz, RET_HEADS, RET_DK, RET_DV), jnp.float32)
        o_c, s_fwd, s_bwd = bidir_retention(q_c, k_c, v_c, log_g, s0, s0)
        y_ctx = merge_branches(o_c, g_c, b_c, c_c, u_c, gate_c, conv_w, w_ret_out, w_conv_out, w_o)
    else:
        k_c, v_c = jnp.split(h_ctx @ w_in[:, RET_QK:2 * RET_QK + RET_V], [RET_QK], axis=-1)
        k_c = k_c.reshape(bsz, t_ctx, RET_HEADS, RET_DK) * k_scale
        v_c = v_c.reshape(bsz, t_ctx, RET_HEADS, RET_DV)
        s_fwd, s_bwd = retention_final_states(k_c, v_c, log_g)
        y_ctx = None
    t = h_lat.shape[1]
    q, k, v, g, cb, cc, cu, gates = jnp.split(h_lat @ w_in, IN_SPLITS, axis=-1)
    q = rope_2d(q.reshape(bsz, t, RET_HEADS, RET_DK), rows, cols)
    k = rope_2d(k.reshape(bsz, t, RET_HEADS, RET_DK) * k_scale, rows, cols)
    v = v.reshape(bsz, t, RET_HEADS, RET_DV)
    o_lat, _, _ = bidir_retention(q, k, v, log_g, s_fwd, s_bwd)
    y_lat = merge_branches(o_lat, g, cb, cc, cu, gates, conv_w, w_ret_out, w_conv_out, w_o)
    return y_lat, y_ctx


def swiglu(h, w_in, w_out):
    gt, up = jnp.split(h @ w_in, 2, axis=-1)
    return (jax.nn.silu(gt) * up) @ w_out


def setup_inputs(seed: int = 0) -> dict:
    key = jax.random.key(seed)
    ks = jax.random.split(key, 17)
    f32 = jnp.float32

    def nrm(k, shape, scale):
        return jax.random.normal(k, shape, f32) * scale

    decay_init = jnp.log(2.0 ** (5.0 + jnp.arange(RET_HEADS, dtype=f32)) - 1.0)
    return {
        'x': nrm(ks[0], (BATCH, SEQ, D_MODEL), 1.0),
        'c': nrm(ks[1], (BATCH, D_MODEL), 1.0),
        'ctx': nrm(ks[2], (BATCH, CTX_LEN, D_MODEL), 1.0),
        'c_ctx': nrm(ks[3], (D_MODEL,), 1.0),
        'norm_mix_w': 1.0 + nrm(ks[4], (DEPTH, D_MODEL), 0.02),
        'ada_w': nrm(ks[5], (DEPTH, D_MODEL, 6 * D_MODEL), 0.5 * D_MODEL ** -0.5),
        'ada_b': nrm(ks[6], (DEPTH, 6 * D_MODEL), 0.01),
        'w_in': nrm(ks[7], (DEPTH, D_MODEL, IN_COLS), D_MODEL ** -0.5),
        'ret_decay_logit': decay_init + nrm(ks[8], (DEPTH, 2, RET_HEADS), 0.1),
        'conv_w': nrm(ks[9], (DEPTH, CONV_K, CONV_WIDTH), CONV_K ** -0.5),
        'w_ret_out': nrm(ks[10], (DEPTH, RET_V, D_MODEL), RET_V ** -0.5),
        'w_conv_out': nrm(ks[11], (DEPTH, CONV_WIDTH, D_MODEL), CONV_WIDTH ** -0.5),
        'w_o': nrm(ks[12], (DEPTH, D_MODEL, D_MODEL), D_MODEL ** -0.5),
        'norm_ffn_w': 1.0 + nrm(ks[13], (DEPTH, D_MODEL), 0.02),
        'w_ffn_in': nrm(ks[14], (DEPTH, D_MODEL, 2 * D_FF), D_MODEL ** -0.5),
        'w_ffn_out': nrm(ks[15], (DEPTH, D_FF, D_MODEL), D_FF ** -0.5),
        'final_norm_w': 1.0 + nrm(ks[16], (D_MODEL,), 0.02),
    }


def reference(x, c, ctx, c_ctx, norm_mix_w, ada_w, ada_b, w_in, ret_decay_logit, conv_w,
              w_ret_out, w_conv_out, w_o, norm_ffn_w, w_ffn_in, w_ffn_out, final_norm_w):
    seq = x.shape[1]
    n_rows = seq // GRID_W
    rows = jnp.broadcast_to(jnp.arange(n_rows)[:, None], (n_rows, GRID_W)).reshape(-1)
    cols = jnp.broadcast_to(jnp.arange(GRID_W)[None, :], (n_rows, GRID_W)).reshape(-1)
    xc = ctx
    for l in range(DEPTH):
        last = l == DEPTH - 1
        m_lat = modulation(c, ada_w[l], ada_b[l])[:, :, None, :]
        m_ctx = modulation(c_ctx, ada_w[l], ada_b[l])
        h_lat = modulate(rms_norm(x, norm_mix_w[l]), m_lat[:, 0], m_lat[:, 1])
        h_ctx = modulate(rms_norm(xc, norm_mix_w[l]), m_ctx[0], m_ctx[1])
        y_lat, y_ctx = hybrid_mixer(h_lat, h_ctx, w_in[l], ret_decay_logit[l], conv_w[l],
                                    w_ret_out[l], w_conv_out[l], w_o[l], rows, cols, not last)
        x = x + m_lat[:, 2] * y_lat
        h = modulate(rms_norm(x, norm_ffn_w[l]), m_lat[:, 3], m_lat[:, 4])
        x = x + m_lat[:, 5] * swiglu(h, w_ffn_in[l], w_ffn_out[l])
        if not last:
            xc = xc + m_ctx[2] * y_ctx
            hc = modulate(rms_norm(xc, norm_ffn_w[l]), m_ctx[3], m_ctx[4])
            xc = xc + m_ctx[5] * swiglu(hc, w_ffn_in[l], w_ffn_out[l])
    return rms_norm(x, final_norm_w)
```

```cpp
#include <hip/hip_runtime.h>
#include <hip/hip_cooperative_groups.h>
#include <cstdio>
#include <cstdint>
namespace cg = cooperative_groups;

#define LAS __attribute__((address_space(3)))
#define GAS __attribute__((address_space(1)))
typedef unsigned short bf16_t;
typedef short bf16x8 __attribute__((ext_vector_type(8)));
typedef float f32x4 __attribute__((ext_vector_type(4)));
typedef float f32x2 __attribute__((ext_vector_type(2)));
typedef unsigned u32x2 __attribute__((ext_vector_type(2)));
typedef unsigned u32x4 __attribute__((ext_vector_type(4)));
typedef __bf16 bf16x2_t __attribute__((ext_vector_type(2)));

constexpr int D = 1024, NB = 32, T = 2048, TC = 256, NH = 8, DFF = 2816;
constexpr int GB = 8, MG = GB * T, NGROUP = NB / GB, MC = NB * TC;
constexpr int NNAT = 9216;
constexpr int KTLD = 16384, KTROWS = 1152;
constexpr float EPS = 1e-6f;

constexpr size_t WS_SC = 0;
constexpr size_t WS_L2G = WS_SC + 33 * 1024 * 4;
constexpr size_t WS_BAR = WS_L2G + 4096;
constexpr size_t WS_ZERO = WS_BAR + 16384;
constexpr size_t WS_ROPE = WS_ZERO + 4096;
constexpr size_t WS_MOD = WS_ROPE + 4 * 8192;
constexpr size_t WS_WNAT = (WS_MOD + 2 * 33 * 6144 * 4 + 4095) & ~size_t(4095);
constexpr size_t WS_WKN = WS_WNAT + (size_t)2 * NNAT * 1024 * 2;
constexpr size_t WS_WY = WS_WKN + (size_t)2 * 3072 * 1024 * 2;
constexpr size_t WS_WO = WS_WY + (size_t)2 * 1024 * 3072 * 2;
constexpr size_t WS_WFI = WS_WO + (size_t)2 * 1024 * 1024 * 2;
constexpr size_t WS_WFO = WS_WFI + (size_t)2 * 5632 * 1024 * 2;
constexpr size_t WS_XC = WS_WFO + (size_t)2 * 1024 * 2816 * 2;
constexpr size_t WS_CKT = WS_XC + (size_t)MC * 1024 * 4;
constexpr size_t WS_CBB = WS_CKT + (size_t)2 * KTROWS * KTLD * 2;
constexpr size_t WS_H = WS_CBB + (size_t)256 * 256 * 512 * 2;
constexpr size_t WS_Q = WS_H + (size_t)MG * 1024 * 2;
constexpr size_t WS_K = WS_Q + (size_t)MG * 1024 * 2;
constexpr size_t WS_KT = WS_K + (size_t)MG * 1024 * 2;
constexpr size_t WS_SG = WS_KT + (size_t)2 * KTROWS * KTLD * 2;
constexpr size_t WS_CONV = WS_SG + (size_t)MG * 2048 * 2;
constexpr size_t WS_GATES = WS_CONV + (size_t)MG * 3072 * 2;
constexpr size_t WS_ABUF = WS_GATES + (size_t)MG * 2048 * 2;
constexpr size_t WS_BBUF = WS_ABUF + (size_t)512 * 256 * 512 * 2;
constexpr size_t WS_END = WS_BBUF + (size_t)512 * 256 * 512 * 2;
constexpr size_t WS_O = WS_H;
constexpr size_t WS_Y = WS_ABUF;
constexpr size_t WS_MRG = WS_BBUF;
constexpr size_t WS_H2 = WS_BBUF + (size_t)MG * 1024 * 2;
constexpr size_t WS_U = WS_SG;
constexpr size_t SLOTB = (size_t)256 * 512 * 2;

constexpr int LDS_BYTES = 143360;
constexpr int XLD = 5120;

__device__ __forceinline__ unsigned cvtpk(float lo, float hi) { f32x2 v = {lo, hi}; bf16x2_t b = __builtin_convertvector(v, bf16x2_t); return __builtin_bit_cast(unsigned, b); }
__device__ __forceinline__ void store4(bf16_t* p, f32x4 v) { u32x2 w; w.x = cvtpk(v[0], v[1]); w.y = cvtpk(v[2], v[3]); *(GAS u32x2*)p = w; }
__device__ __forceinline__ f32x4 load4(const bf16_t* p) { const u32x2 w = *(const GAS u32x2*)p; f32x4 v; v[0] = __uint_as_float(w.x << 16); v[1] = __uint_as_float(w.x & 0xffff0000u); v[2] = __uint_as_float(w.y << 16); v[3] = __uint_as_float(w.y & 0xffff0000u); return v; }
__device__ __forceinline__ float sigmoidf_(float x) { return __builtin_amdgcn_rcpf(1.0f + __builtin_amdgcn_exp2f(x * -1.4426950408889634f)); }
__device__ __forceinline__ unsigned char* lw(unsigned char* p) { asm volatile("" : "+s"(p));
#if defined(__HIP_DEVICE_COMPILE__)
    __builtin_assume(!__builtin_amdgcn_is_shared(p)); __builtin_assume(!__builtin_amdgcn_is_private(p));
#endif
    return p; }
__device__ __forceinline__ float wave_sum(float v) {
#pragma unroll
    for (int o = 32; o > 0; o >>= 1) v += __shfl_xor(v, o);
    return v;
}


#define XB_TMO      128
#define XB_XCNT(j)  (256  + 64 * (j))
#define XB_XSUB(j)  (1280 + 64 * (j))
#define XB_XGEN(j)  (2304 + 64 * (j))
#define XB_TOP      3328
#define XB_TOPGEN   3392
#define XCD_BAR_WORDS 3456
#define XB_SPIN_CAP (1u << 22)
__device__ __forceinline__ unsigned xb_ld(unsigned* p)              { return __hip_atomic_load(p, __ATOMIC_RELAXED, __HIP_MEMORY_SCOPE_AGENT); }
__device__ __forceinline__ unsigned xb_add(unsigned* p, unsigned v) { return __hip_atomic_fetch_add(p, v, __ATOMIC_RELAXED, __HIP_MEMORY_SCOPE_AGENT); }
__device__ __forceinline__ unsigned xb_xcc_id() { return (unsigned)__builtin_amdgcn_s_getreg((3 << 11) | 20) & 0xFu; }
#define XB_SPIN(cond, bar) do { unsigned _sp = 0; while (cond) { __builtin_amdgcn_s_sleep(1); \
    if ((++_sp & 255u) == 0u) { if (xb_ld(&(bar)[XB_TMO])) break; if (_sp > XB_SPIN_CAP) { atomicAdd(&(bar)[XB_TMO], 1u); break; } } } } while (0)
struct XcdBarrier { unsigned* bar; unsigned x; volatile LAS unsigned* st; };
__device__ __forceinline__ XcdBarrier xcd_barrier_post(unsigned* bar, volatile LAS unsigned* st) {
    XcdBarrier b; b.bar = bar; b.x = xb_xcc_id(); b.st = st;
    if (threadIdx.x == 0) (void)xb_add(&bar[XB_XCNT(b.x)], 1u);
    return b;
}
__device__ __forceinline__ void xcd_barrier_complete(unsigned* bar, unsigned x, unsigned& nloc, unsigned& nx) {
    const unsigned G = gridDim.x * gridDim.y * gridDim.z;
    unsigned sum, cnt, mine, sp = 0u;
    for (;;) {
        sum = 0u; cnt = 0u; mine = 0u;
#pragma unroll
        for (unsigned j = 0; j < 16; ++j) { const unsigned c = xb_ld(&bar[XB_XCNT(j)]); sum += c; cnt += (c > 0u) ? 1u : 0u; mine = (j == x) ? c : mine; }
        if (sum == G) break;
        __builtin_amdgcn_s_sleep(1);
        if ((++sp & 255u) == 0u) { if (xb_ld(&bar[XB_TMO])) break; if (sp > XB_SPIN_CAP) { atomicAdd(&bar[XB_TMO], 1u); break; } }
    }
    nloc = mine > 0u ? mine : 1u; nx = cnt > 0u ? cnt : 1u;
}
__device__ __forceinline__ void xcd_barrier(const XcdBarrier& b) {
    asm volatile("s_waitcnt vmcnt(0)" ::: "memory");
    __syncthreads();
    if (threadIdx.x == 0) {
        unsigned* bar = b.bar; unsigned bx = b.x; asm volatile("" : "+s"(bar), "+s"(bx));
        __builtin_amdgcn_s_waitcnt(0);
        unsigned nloc = b.st[0], nx = b.st[1];
        if (nloc == 0u) { xcd_barrier_complete(bar, bx, nloc, nx); b.st[0] = nloc; b.st[1] = nx; }
        const unsigned old = xb_add(&bar[XB_XSUB(bx)], 1u);
        const unsigned gen = old / nloc;
        if (old + 1u == (gen + 1u) * nloc) {
            __builtin_amdgcn_fence(__ATOMIC_RELEASE, "agent");
            asm volatile("s_waitcnt vmcnt(0)" ::: "memory");
            const unsigned og = xb_add(&bar[XB_TOP], 1u);
            const unsigned tg = og / nx;
            if (og + 1u == (tg + 1u) * nx) xb_add(&bar[XB_TOPGEN], 1u);
            else XB_SPIN(xb_ld(&bar[XB_TOPGEN]) == tg, bar);
            __builtin_amdgcn_fence(__ATOMIC_ACQUIRE, "agent");
            xb_add(&bar[XB_XGEN(bx)], 1u);
            asm volatile("s_waitcnt vmcnt(0)" ::: "memory");
        } else {
            XB_SPIN(xb_ld(&bar[XB_XGEN(bx)]) == gen, bar);
            __builtin_amdgcn_fence(__ATOMIC_ACQUIRE, "agent");
            asm volatile("s_waitcnt vmcnt(0)" ::: "memory");
        }
    }
    __syncthreads();
}

namespace pg8 {
constexpr int BM = 256, BK = 64, HALF = 128, HTB = HALF * BK * 2;
__device__ __forceinline__ int lds_byte(int r, int c) { const int st = (r >> 4) * 2 + (c >> 5), rr = r & 15, cc = c & 31, ob = rr * 64 + cc * 2; return st * 1024 + (ob ^ (((ob >> 9) & 1) << 5)); }
__device__ __forceinline__ void stage_rc(int b, int& R, int& C) { const int st = b / 1024, sb = b % 1024, swz = sb ^ (((sb >> 9) & 1) << 5); R = (st >> 1) * 16 + swz / 64; C = (st & 1) * 32 + (swz % 64) / 2; }

struct Unit { const char* A; const char* B; int pm, pn, f; float sc; };
typedef f32x4 Acc[2][2][4][2];

struct Order2D {
    int nM, nN, nwg, G, c;
    __device__ void init(int nM_, int nN_, int G_, int c_) { nM = nM_; nN = nN_; nwg = nM * nN; G = G_; c = c_; }
    __device__ bool get(int i, int& pm, int& pn) const {
        const long L = (long)i * G + c; if (L >= nwg) return false;
        int wgid = (int)L; { const int q = nwg / 8, r = nwg % 8, xcd = wgid % 8, off = wgid / 8; wgid = (xcd < r ? xcd * (q + 1) : r * (q + 1) + (xcd - r) * q) + off; }
        const int nig = 8 * nN, gid = wgid / nig, fm = gid * 8, gsz = (nM - fm) < 8 ? (nM - fm) : 8;
        pm = fm + ((wgid % nig) % gsz); pn = (wgid % nig) / gsz; return true;
    }
};

template <class Epi, class Sched>
__device__ __forceinline__ void gemm_phase(LAS unsigned char* lds, const int lda, const int ldb, const int K, const Sched& S, const Epi& E) {
    int tid_ = threadIdx.x; asm volatile("" : "+v"(tid_));
    const int tid = tid_, wid = __builtin_amdgcn_readfirstlane(tid >> 6), lane = tid & 63, wr = wid >> 2, wc = wid & 3, fr = lane & 15, fq = lane >> 4;
    const int nt = K / BK;
    unsigned voffA[2], voffB[2];
#pragma unroll
    for (int i = 0; i < 2; ++i) { int R, C; stage_rc(tid * 16 + i * 8192, R, C); const int rho = R & 31; const int Rb = Epi::PERM ? ((R & ~31) + 8 * ((rho & 15) >> 2) + 4 * (rho >> 4) + (rho & 3)) : R;
        voffA[i] = (unsigned)(R * lda + C) * 2u; voffB[i] = (unsigned)(Rb * ldb + C) * 2u; }
    const size_t kstep = (size_t)(BK * 2);
    const size_t hstepA = (size_t)HALF * lda * 2, hstepB = (size_t)HALF * ldb * 2;
    const unsigned ldsw = (unsigned)wid * 1024u;
    const int aoff = lds_byte(wr * 64 + fr, fq * 8), boff = lds_byte(wc * 32 + fr, fq * 8);
#define PG8_SA(b, h) (((b) * 2 + (h)) * HTB)
#define PG8_SB(b, h) ((4 + (b) * 2 + (h)) * HTB)
#define PG8_STAGE(bufoff, gbase, voff) do { _Pragma("unroll") for (int _i = 0; _i < 2; ++_i) \
        __builtin_amdgcn_global_load_lds((const unsigned*)((const char*)(gbase) + (voff)[_i]), (LAS unsigned*)(lds + (bufoff) + ldsw + _i * 8192), 16, 0, 0); } while (0)
#define PG8_LDA(dst, b, h) do { _Pragma("unroll") for (int m = 0; m < 4; ++m) _Pragma("unroll") for (int k = 0; k < 2; ++k) dst[m][k] = *(const LAS bf16x8*)(lds + PG8_SA(b, h) + aoff + m * 2048 + k * 1024); } while (0)
#define PG8_LDB(dst, b, h) do { _Pragma("unroll") for (int n = 0; n < 2; ++n) _Pragma("unroll") for (int k = 0; k < 2; ++k) dst[n][k] = *(const LAS bf16x8*)(lds + PG8_SB(b, h) + boff + n * 2048 + k * 1024); } while (0)
#define PG8_MMA(ai, bj, At, Bt) do { __builtin_amdgcn_s_setprio(1); _Pragma("unroll") for (int m = 0; m < 4; ++m) _Pragma("unroll") for (int n = 0; n < 2; ++n) _Pragma("unroll") for (int k = 0; k < 2; ++k) \
        acc[ai][bj][m][n] = __builtin_amdgcn_mfma_f32_16x16x32_bf16(Bt[n][k], At[m][k], acc[ai][bj][m][n], 0, 0, 0); __builtin_amdgcn_s_setprio(0); } while (0)
#define PG8_MMA1(ai, At) do { if constexpr (!Epi::HALF_N) PG8_MMA(ai, 1, At, B1); } while (0)
#define PG8_WAIT_V(n) asm volatile("s_waitcnt vmcnt(" #n ")" ::: "memory")
#define PG8_WAIT_L(n) asm volatile("s_waitcnt lgkmcnt(" #n ")" ::: "memory")
#define PG8_BAR __builtin_amdgcn_s_barrier()
#define PG8_SCHED __builtin_amdgcn_sched_barrier(0)
    Unit cur, nxt; int ui = 0;
    if (!S.next(0, cur)) return;
    Acc acc;
#pragma unroll
    for (int a = 0; a < 2; ++a)
#pragma unroll
        for (int b = 0; b < 2; ++b)
#pragma unroll
            for (int m = 0; m < 4; ++m)
#pragma unroll
                for (int n = 0; n < 2; ++n) acc[a][b][m][n] = (f32x4){0.f, 0.f, 0.f, 0.f};
    bf16x8 At[4][2], B0[2][2], B1[2][2];
    const char* cA = cur.A; const char* cB = cur.B;
#define PG8_STAGE_B1(bufoff, gbase) do { if constexpr (!Epi::HALF_N) PG8_STAGE(bufoff, gbase, voffB); } while (0)
#define PG8_LDB1(dst, b) do { if constexpr (!Epi::HALF_N) PG8_LDB(dst, b, 1); } while (0)
#define PG8_WAIT_VL do { if constexpr (Epi::HALF_N) PG8_WAIT_V(6); else PG8_WAIT_V(8); } while (0)
    PG8_STAGE(PG8_SB(0, 0), cB, voffB); PG8_STAGE_B1(PG8_SB(0, 1), cB + hstepB); PG8_STAGE(PG8_SA(0, 0), cA, voffA); PG8_STAGE(PG8_SA(0, 1), cA + hstepA, voffA);
    if (wr == 1) PG8_BAR;
    PG8_WAIT_V(2); PG8_BAR;
    PG8_STAGE(PG8_SB(1, 0), cB + kstep, voffB); PG8_STAGE(PG8_SA(1, 0), cA + kstep, voffA); PG8_STAGE_B1(PG8_SB(1, 1), cB + hstepB + kstep);
    if constexpr (Epi::HALF_N) PG8_WAIT_V(4); else PG8_WAIT_V(6);
    PG8_BAR;
    for (;;) {
        const bool has_next = S.next(ui + 1, nxt);
        const char* nA = has_next ? nxt.A : cA; const char* nB = has_next ? nxt.B : cB;
        for (int t = 0; t < nt; t += 2) {
            const bool last = (t == nt - 2);
            const char* a1 = cA + (size_t)(t + 1) * kstep;
            const char* a2 = last ? nA : cA + (size_t)(t + 2) * kstep; const char* b2 = last ? nB : cB + (size_t)(t + 2) * kstep;
            const char* a3 = a2 + kstep; const char* b3 = b2 + kstep;
            if constexpr (Epi::HAS_MID) { if (t == E.mid_t) { int fr2 = fr, fq2 = fq; asm volatile("" : "+v"(fr2), "+v"(fq2)); E.mid(acc, cur, wr, wc, fr2, fq2); } }
            PG8_LDB(B0, 0, 0); PG8_LDB1(B1, 0); PG8_SCHED; PG8_LDA(At, 0, 0); PG8_STAGE(PG8_SA(1, 1), a1 + hstepA, voffA);
            PG8_WAIT_VL; PG8_WAIT_L(0); PG8_BAR; PG8_MMA(0, 0, At, B0); PG8_MMA1(0, At); PG8_BAR; PG8_SCHED;
            PG8_LDA(At, 0, 1); PG8_STAGE(PG8_SB(0, 0), b2, voffB); PG8_STAGE_B1(PG8_SB(0, 1), b2 + hstepB); PG8_STAGE(PG8_SA(0, 0), a2, voffA);
            PG8_WAIT_VL; PG8_WAIT_L(0); PG8_BAR; PG8_MMA(1, 0, At, B0); PG8_MMA1(1, At); PG8_BAR; PG8_SCHED;
            PG8_LDB(B0, 1, 0); PG8_LDB1(B1, 1); PG8_SCHED; PG8_LDA(At, 1, 0); PG8_STAGE(PG8_SA(0, 1), a2 + hstepA, voffA);
            PG8_WAIT_VL; PG8_WAIT_L(0); PG8_BAR; PG8_MMA(0, 0, At, B0); PG8_MMA1(0, At); PG8_BAR; PG8_SCHED;
            PG8_LDA(At, 1, 1); PG8_STAGE(PG8_SB(1, 0), b3, voffB); PG8_STAGE_B1(PG8_SB(1, 1), b3 + hstepB); PG8_STAGE(PG8_SA(1, 0), a3, voffA);
            PG8_WAIT_VL; PG8_WAIT_L(0); PG8_BAR; PG8_MMA(1, 0, At, B0); PG8_MMA1(1, At); PG8_BAR; PG8_SCHED;
        }
        if (wr == 0) PG8_BAR;
        { int fr2 = fr, fq2 = fq; asm volatile("" : "+v"(fr2), "+v"(fq2)); E(acc, cur, wr, wc, fr2, fq2); }
        if (!has_next) break;
        if (Epi::CARRY && !(nxt.f & 1)) {
            const float s = nxt.sc;
#pragma unroll
            for (int a = 0; a < 2; ++a)
#pragma unroll
                for (int b = 0; b < 2; ++b)
#pragma unroll
                    for (int m = 0; m < 4; ++m)
#pragma unroll
                        for (int n = 0; n < 2; ++n) acc[a][b][m][n] = acc[a][b][m][n] * s;
        } else {
#pragma unroll
            for (int a = 0; a < 2; ++a)
#pragma unroll
                for (int b = 0; b < 2; ++b)
#pragma unroll
                    for (int m = 0; m < 4; ++m)
#pragma unroll
                        for (int n = 0; n < 2; ++n) acc[a][b][m][n] = (f32x4){0.f, 0.f, 0.f, 0.f};
        }
        cur = nxt; cA = nA; cB = nB; ++ui;
        if (wr == 1) PG8_BAR;
    }
    PG8_WAIT_V(0);
    PG8_BAR;
#undef PG8_SA
#undef PG8_SB
#undef PG8_STAGE
#undef PG8_LDA
#undef PG8_LDB
#undef PG8_MMA
#undef PG8_MMA1
#undef PG8_STAGE_B1
#undef PG8_LDB1
#undef PG8_WAIT_VL
#undef PG8_WAIT_V
#undef PG8_WAIT_L
#undef PG8_BAR
#undef PG8_SCHED
}
}
using pg8::Unit; using pg8::Acc;

#define EPI_FLAGS(hm_, carry_, halfn_, perm_) static constexpr bool HAS_MID = hm_, CARRY = carry_, HALF_N = halfn_, PERM = perm_; int mid_t; \
    __device__ __forceinline__ void mid(Acc&, const Unit&, int, int, int, int) const {}
#define FOR_AI_M _Pragma("unroll") for (int ai = 0; ai < 2; ++ai) _Pragma("unroll") for (int m = 0; m < 4; ++m)
#define FOR_BJ _Pragma("unroll") for (int bj = 0; bj < 2; ++bj)
__device__ __forceinline__ void store8(bf16_t* p, f32x4 a, f32x4 b) { u32x4 w; w.x = cvtpk(a[0], a[1]); w.y = cvtpk(a[2], a[3]); w.z = cvtpk(b[0], b[1]); w.w = cvtpk(b[2], b[3]); *(GAS u32x4*)p = w; }
__device__ __forceinline__ void load8(const bf16_t* p, f32x4& a, f32x4& b) { const u32x4 w = *(const GAS u32x4*)p;
    a[0] = __uint_as_float(w.x << 16); a[1] = __uint_as_float(w.x & 0xffff0000u); a[2] = __uint_as_float(w.y << 16); a[3] = __uint_as_float(w.y & 0xffff0000u);
    b[0] = __uint_as_float(w.z << 16); b[1] = __uint_as_float(w.z & 0xffff0000u); b[2] = __uint_as_float(w.w << 16); b[3] = __uint_as_float(w.w & 0xffff0000u); }
__device__ __forceinline__ f32x4 sig4(f32x4 v) { f32x4 r; r[0] = sigmoidf_(v[0]); r[1] = sigmoidf_(v[1]); r[2] = sigmoidf_(v[2]); r[3] = sigmoidf_(v[3]); return r; }

struct EpiNat {
    EPI_FLAGS(false, false, false, false)
    bf16_t *q, *sg, *abuf, *kft; const float *cosT, *sinT, *l2g; int nch, rope;
    __device__ __forceinline__ void operator()(Acc& acc, const Unit& u, int wr, int wc, int fr, int fq) const {
        const int pn = u.pn;
        if (pn < 8) {
            const bool isq = pn < 4; bf16_t* dst = q + (isq ? (size_t)0 : (size_t)MG * 1024);
            const int head = 2 * (pn & 3) + (wc >> 1), type = wc & 1, i0 = 8 * fq, dbase = (type ? 64 : 0) + i0;
            const float lf = l2g[head], lb = l2g[8 + head];
            FOR_AI_M {
                const int r = 128 * ai + 64 * wr + 16 * m + fr; const size_t R = (size_t)u.pm * 256 + r;
                f32x4 cs0 = {1.f, 1.f, 1.f, 1.f}, cs1 = cs0, sn0 = {0.f, 0.f, 0.f, 0.f}, sn1 = sn0;
                if (rope) { const int t = (int)(R & 2047); const int pos = type ? (t & 63) : (t >> 6);
                    cs0 = *(const GAS f32x4*)(cosT + pos * 32 + i0); cs1 = *(const GAS f32x4*)(cosT + pos * 32 + i0 + 4); sn0 = *(const GAS f32x4*)(sinT + pos * 32 + i0); sn1 = *(const GAS f32x4*)(sinT + pos * 32 + i0 + 4); }
                const f32x4 a0 = acc[ai][0][m][0], a1 = acc[ai][0][m][1], b0 = acc[ai][1][m][0], b1 = acc[ai][1][m][1];
                const f32x4 o10 = a0 * cs0 - b0 * sn0, o11 = a1 * cs1 - b1 * sn1, o20 = a0 * sn0 + b0 * cs0, o21 = a1 * sn1 + b1 * cs1;
                if (!isq) { bf16_t* rowp = dst + R * 1024 + head * 128 + dbase; store8(rowp, o10, o11); store8(rowp + 32, o20, o21); }
                if (!isq) {
                    const float wkf = __builtin_amdgcn_exp2f(lf * (float)(255 - r)), wkb = __builtin_amdgcn_exp2f(lb * (float)r);
                    GAS unsigned short* kp = (GAS unsigned short*)(kft + ((size_t)u.pm * KTROWS + head * 128 + dbase) * 256 + r);
                    GAS unsigned short* kq = kp + (size_t)64 * KTROWS * 256;
#pragma unroll
                    for (int j = 0; j < 4; ++j) {
                        kp[(size_t)j * 256] = (unsigned short)cvtpk(o10[j] * wkf, 0.f); kp[(size_t)(4 + j) * 256] = (unsigned short)cvtpk(o11[j] * wkf, 0.f);
                        kp[(size_t)(32 + j) * 256] = (unsigned short)cvtpk(o20[j] * wkf, 0.f); kp[(size_t)(36 + j) * 256] = (unsigned short)cvtpk(o21[j] * wkf, 0.f);
                        kq[(size_t)j * 256] = (unsigned short)cvtpk(o10[j] * wkb, 0.f); kq[(size_t)(4 + j) * 256] = (unsigned short)cvtpk(o11[j] * wkb, 0.f);
                        kq[(size_t)(32 + j) * 256] = (unsigned short)cvtpk(o20[j] * wkb, 0.f); kq[(size_t)(36 + j) * 256] = (unsigned short)cvtpk(o21[j] * wkb, 0.f);
                    }
                }
                if (isq) {
                    const int slot = ((u.pm / nch) * 8 + head) * nch + (u.pm % nch);
                    const float wf = __builtin_amdgcn_exp2f(lf * (float)(r + 1)), wb = __builtin_amdgcn_exp2f(lb * (float)(256 - r));
                    bf16_t* ap = abuf + ((size_t)slot * 256 + r) * 512 + 256 + dbase;
                    store8(ap, o10 * wf, o11 * wf); store8(ap + 32, o20 * wf, o21 * wf); store8(ap + 128, o10 * wb, o11 * wb); store8(ap + 160, o20 * wb, o21 * wb);
                }
            }
        } else {
            size_t doff; int ld, c0, act;
            if (pn < 16) { doff = 0; ld = XLD; c0 = (pn - 8) * 256; act = 1; }
            else if (pn < 20) { doff = 0; ld = XLD; c0 = 2048 + (pn - 16) * 256; act = 0; }
            else if (pn < 28) {
                FOR_AI_M { const int r = 128 * ai + 64 * wr + 16 * m + fr; const size_t R = (size_t)u.pm * 256 + r;
                    store8(sg + R * XLD + 3072 + (pn - 20) * 128 + 32 * wc + 8 * fq, acc[ai][0][m][0] * acc[ai][1][m][0], acc[ai][0][m][1] * acc[ai][1][m][1]); }
                return;
            }
            else {
                bf16_t* gb = sg + (size_t)MG * XLD;
                FOR_AI_M { const int r = 128 * ai + 64 * wr + 16 * m + fr; const size_t R = (size_t)u.pm * 256 + r;
                    f32x4 rt[2], gc[2];
#pragma unroll
                    for (int n = 0; n < 2; ++n)
#pragma unroll
                        for (int j = 0; j < 4; ++j) { const float ea = __builtin_amdgcn_exp2f(acc[ai][0][m][n][j] * -1.4426950408889634f), eb = __builtin_amdgcn_exp2f(acc[ai][1][m][n][j] * -1.4426950408889634f);
                            gc[n][j] = __builtin_amdgcn_rcpf(1.0f + eb); rt[n][j] = (1.0f + eb) * __builtin_amdgcn_rcpf(1.0f + ea); }
                    bf16_t* gp = gb + R * 2048 + (pn - 28) * 128 + 32 * wc + 8 * fq;
                    store8(gp, rt[0], rt[1]); store8(gp + 1024, gc[0], gc[1]); }
                return;
            }
            bf16_t* dst = sg + doff;
            FOR_AI_M {
                const int r = 128 * ai + 64 * wr + 16 * m + fr; const size_t R = (size_t)u.pm * 256 + r;
                FOR_BJ {
                    f32x4 v0 = acc[ai][bj][m][0], v1 = acc[ai][bj][m][1];
                    if (act == 1) { v0 = v0 * sig4(v0); v1 = v1 * sig4(v1); }
                    else if (act == 2) { v0 = sig4(v0); v1 = sig4(v1); }
                    store8(dst + R * ld + c0 + 128 * bj + 32 * wc + 8 * fq, v0, v1);
                }
            }
        }
    }
};

struct EpiKT {
    EPI_FLAGS(false, false, false, true)
    bf16_t *kft, *kbt; const float *cosT, *sinT, *cosT2, *sinT2, *l2g; int rope;
    __device__ __forceinline__ void operator()(Acc& acc, const Unit& u, int wr, int wc, int fr, int fq) const {
#pragma unroll
        for (int ai = 0; ai < 2; ++ai) {
            const int head = 2 * u.pm + ai; const float lf = l2g[head], lb = l2g[8 + head];
            FOR_BJ {
                const int c0 = 128 * bj + 32 * wc + 8 * fq;
                f32x4 wf0, wf1, wb0, wb1;
#pragma unroll
                for (int j = 0; j < 4; ++j) { wf0[j] = __builtin_amdgcn_exp2f(lf * (float)(255 - (c0 + j))); wf1[j] = __builtin_amdgcn_exp2f(lf * (float)(251 - (c0 + j))); wb0[j] = __builtin_amdgcn_exp2f(lb * (float)(c0 + j)); wb1[j] = __builtin_amdgcn_exp2f(lb * (float)(c0 + 4 + j)); }
#pragma unroll
                for (int mm = 0; mm < 2; ++mm) {
                    const int i = 16 * mm + fr;
                    f32x4 cs0 = {1.f, 1.f, 1.f, 1.f}, cs1 = cs0, sn0 = {0.f, 0.f, 0.f, 0.f}, sn1 = sn0;
                    if (rope) {
                        if (wr == 1) { const int pos0 = c0 & 63; cs0 = *(const GAS f32x4*)(cosT2 + i * 64 + pos0); cs1 = *(const GAS f32x4*)(cosT2 + i * 64 + pos0 + 4); sn0 = *(const GAS f32x4*)(sinT2 + i * 64 + pos0); sn1 = *(const GAS f32x4*)(sinT2 + i * 64 + pos0 + 4); }
                        else { const int pos = (((u.pn & 7) * 256 + c0) >> 6); const float c = cosT[pos * 32 + i], sv = sinT[pos * 32 + i]; cs0 = (f32x4){c, c, c, c}; cs1 = cs0; sn0 = (f32x4){sv, sv, sv, sv}; sn1 = sn0; }
                    }
                    const f32x4 a0 = acc[ai][bj][mm][0], a1 = acc[ai][bj][mm][1], b0 = acc[ai][bj][mm + 2][0], b1 = acc[ai][bj][mm + 2][1];
                    const f32x4 o10 = a0 * cs0 - b0 * sn0, o11 = a1 * cs1 - b1 * sn1, o20 = a0 * sn0 + b0 * cs0, o21 = a1 * sn1 + b1 * cs1;
                    const size_t row1 = (size_t)head * 128 + 64 * wr + 16 * mm + fr, row2 = row1 + 32;
                    const size_t tb = (size_t)u.pn * KTROWS;
                    store8(kft + (tb + row1) * 256 + c0, o10 * wf0, o11 * wf1); store8(kft + (tb + row2) * 256 + c0, o20 * wf0, o21 * wf1);
                    store8(kbt + (tb + row1) * 256 + c0, o10 * wb0, o11 * wb1); store8(kbt + (tb + row2) * 256 + c0, o20 * wb0, o21 * wb1);
                }
            }
        }
    }
};

struct EpiVT {
    EPI_FLAGS(false, false, false, true)
    bf16_t* bbuf; int nch;
    __device__ __forceinline__ void operator()(Acc& acc, const Unit& u, int wr, int wc, int fr, int fq) const {
        const int slot = ((u.pn / nch) * 8 + u.pm) * nch + (u.pn % nch);
        bf16_t* dst = bbuf + (size_t)slot * 256 * 512;
        FOR_AI_M { const int dv = 128 * ai + 64 * wr + 16 * m + fr;
            FOR_BJ store8(dst + (size_t)dv * 512 + 128 * bj + 32 * wc + 8 * fq, acc[ai][bj][m][0], acc[ai][bj][m][1]); }
    }
};

struct EpiKV {
    EPI_FLAGS(false, false, false, true)
    EpiKT kt; EpiVT vt;
    __device__ __forceinline__ void operator()(Acc& acc, const Unit& u, int wr, int wc, int fr, int fq) const {
        if (u.pm < 4) kt(acc, u, wr, wc, fr, fq);
        else { Unit v = u; v.pm = u.pm - 4; vt(acc, v, wr, wc, fr, fq); }
    }
};

struct EpiScores {
    EPI_FLAGS(false, false, false, true)
    bf16_t* abuf; const float* l2g;
    __device__ __forceinline__ void operator()(Acc& acc, const Unit& u, int wr, int wc, int fr, int fq) const {
        const float lf = l2g[u.pn], lb = l2g[8 + u.pn];
        bf16_t* dst = abuf + (size_t)u.pm * 256 * 512;
        FOR_AI_M { const int t = 128 * ai + 64 * wr + 16 * m + fr; const float rowe = -lf * (float)(t + 1);
            FOR_BJ { const int c0 = 128 * bj + 32 * wc + 8 * fq; f32x4 v0 = acc[ai][bj][m][0], v1 = acc[ai][bj][m][1];
#pragma unroll
                for (int j = 0; j < 4; ++j) {
                    const int d0 = t - (c0 + j), d1 = d0 - 4;
                    v0[j] *= __builtin_amdgcn_exp2f((d0 >= 0 ? lf : -lb) * (float)d0 + (d0 == 0 ? rowe + 1.0f : rowe));
                    v1[j] *= __builtin_amdgcn_exp2f((d1 >= 0 ? lf : -lb) * (float)d1 + (d1 == 0 ? rowe + 1.0f : rowe)); }
                store8(dst + (size_t)t * 512 + c0, v0, v1); } }
    }
};

struct EpiChain {
    EPI_FLAGS(false, true, true, true)
    bf16_t* bbuf;
    __device__ __forceinline__ void operator()(Acc& acc, const Unit& u, int wr, int wc, int fr, int fq) const {
        if (u.pm < 0) return;
        bf16_t* dst = bbuf + (size_t)u.pm * 256 * 512 + u.pn;
        FOR_AI_M { const int dv = 128 * ai + 64 * wr + 16 * m + fr;
            store8(dst + (size_t)dv * 512 + 32 * wc + 8 * fq, acc[ai][0][m][0], acc[ai][0][m][1]); }
    }
};

__device__ __forceinline__ void unpack8(const u32x4 w, f32x4& a, f32x4& b) {
    a[0] = __uint_as_float(w.x << 16); a[1] = __uint_as_float(w.x & 0xffff0000u); a[2] = __uint_as_float(w.y << 16); a[3] = __uint_as_float(w.y & 0xffff0000u);
    b[0] = __uint_as_float(w.z << 16); b[1] = __uint_as_float(w.z & 0xffff0000u); b[2] = __uint_as_float(w.w << 16); b[3] = __uint_as_float(w.w & 0xffff0000u); }
struct EpiO {
    EPI_FLAGS(false, false, false, true)
    bf16_t* xb; LAS unsigned char* xl; bf16_t* ob; int opitch;
    __device__ __forceinline__ void operator()(Acc& acc, const Unit& u, int wr, int wc, int fr, int fq) const {
        LAS f32x2* P = (LAS f32x2*)xl;
        bf16_t* obase = ob + ((size_t)u.f * 256 + 64 * wr + fr) * opitch + u.pn * 256 + 32 * wc + 8 * fq;
        bf16_t* base = xb + ((size_t)u.f * 256 + 64 * wr + fr) * XLD + u.pn * 256 + 32 * wc + 8 * fq;
        u32x4 gp[2][4][2];
        FOR_AI_M { FOR_BJ gp[ai][m][bj] = *(const GAS u32x4*)(base + (size_t)(128 * ai + 16 * m) * XLD + 128 * bj); }
        FOR_AI_M {
            float sm = 0.f;
            FOR_BJ { const f32x4 a = acc[ai][bj][m][0], b = acc[ai][bj][m][1]; sm += ((a[0] + a[1]) + (a[2] + a[3])) + ((b[0] + b[1]) + (b[2] + b[3])); }
            sm += __shfl_xor(sm, 16); sm += __shfl_xor(sm, 32);
            const float mw = sm * (1.0f / 64.0f); float qv = 0.f;
            FOR_BJ { const f32x4 a = acc[ai][bj][m][0] - mw, b = acc[ai][bj][m][1] - mw; qv += ((a[0] * a[0] + a[1] * a[1]) + (a[2] * a[2] + a[3] * a[3])) + ((b[0] * b[0] + b[1] * b[1]) + (b[2] * b[2] + b[3] * b[3])); }
            qv += __shfl_xor(qv, 16); qv += __shfl_xor(qv, 32);
            if (fq == 0) P[(128 * ai + 64 * wr + 16 * m + fr) * 4 + wc] = (f32x2){mw, qv};
        }
        asm volatile("s_waitcnt lgkmcnt(0)" ::: "memory"); __builtin_amdgcn_s_barrier(); asm volatile("" ::: "memory");
        FOR_AI_M {
            const int r = 128 * ai + 64 * wr + 16 * m + fr;
            const f32x2 p0 = P[r * 4 + 0], p1 = P[r * 4 + 1], p2 = P[r * 4 + 2], p3 = P[r * 4 + 3];
            const float mt = ((p0.x + p1.x) + (p2.x + p3.x)) * 0.25f;
            const float d0 = p0.x - mt, d1 = p1.x - mt, d2 = p2.x - mt, d3 = p3.x - mt;
            const float m2 = ((p0.y + p1.y) + (p2.y + p3.y)) + 64.0f * ((d0 * d0 + d1 * d1) + (d2 * d2 + d3 * d3));
            const float rs = rsqrtf(m2 * (1.0f / 256.0f) + EPS);
            FOR_BJ { f32x4 g0, g1; unpack8(gp[ai][m][bj], g0, g1);
                store8(obase + (size_t)(128 * ai + 16 * m) * opitch + 128 * bj, (acc[ai][bj][m][0] - mt) * rs * g0, (acc[ai][bj][m][1] - mt) * rs * g1); }
        }
        asm volatile("s_waitcnt lgkmcnt(0)" ::: "memory"); __builtin_amdgcn_s_barrier(); asm volatile("" ::: "memory");
    }
};

struct EpiMerge {
    static constexpr bool HAS_MID = true, CARRY = false, HALF_N = false, PERM = true; int mid_t;
    const bf16_t* gates; bf16_t* mrg;
    __device__ __forceinline__ void mid(Acc& acc, const Unit& u, int wr, int wc, int fr, int fq) const {
        FOR_AI_M { const size_t R = (size_t)u.pm * 256 + 128 * ai + 64 * wr + 16 * m + fr;
            FOR_BJ { const int col = u.pn * 256 + 128 * bj + 32 * wc + 8 * fq;
                f32x4 r0, r1; load8(gates + R * 2048 + col, r0, r1);
                acc[ai][bj][m][0] = acc[ai][bj][m][0] * r0; acc[ai][bj][m][1] = acc[ai][bj][m][1] * r1; } }
    }
    __device__ __forceinline__ void operator()(Acc& acc, const Unit& u, int wr, int wc, int fr, int fq) const {
        FOR_AI_M { const size_t R = (size_t)u.pm * 256 + 128 * ai + 64 * wr + 16 * m + fr;
            FOR_BJ { const int col = u.pn * 256 + 128 * bj + 32 * wc + 8 * fq;
                f32x4 gc0, gc1; load8(gates + R * 2048 + 1024 + col, gc0, gc1);
                store8(mrg + R * 1024 + col, acc[ai][bj][m][0] * gc0, acc[ai][bj][m][1] * gc1); } }
    }
};

struct EpiRes {
    EPI_FLAGS(false, false, false, true)
    const float* xin; float* xout; const float* mod; int b0, ctx, which; const float* zero;
    __device__ __forceinline__ void operator()(Acc& acc, const Unit& u, int wr, int wc, int fr, int fq) const {
        const float* gv = zero ? zero - (size_t)u.pn * 256 : mod + (size_t)(ctx ? 32 : (b0 + (u.pm >> 3))) * 6144 + which * 1024;
        FOR_BJ { const int col = u.pn * 256 + 128 * bj + 32 * wc + 8 * fq; const f32x4 g0 = *(const GAS f32x4*)(gv + col), g1 = *(const GAS f32x4*)(gv + col + 4);
            FOR_AI_M { const size_t R = (size_t)u.pm * 256 + 128 * ai + 64 * wr + 16 * m + fr;
                const f32x4 x0 = *(const GAS f32x4*)(xin + R * 1024 + col), x1 = *(const GAS f32x4*)(xin + R * 1024 + col + 4);
                *(GAS f32x4*)(xout + R * 1024 + col) = x0 + g0 * acc[ai][bj][m][0]; *(GAS f32x4*)(xout + R * 1024 + col + 4) = x1 + g1 * acc[ai][bj][m][1]; } }
    }
};

struct EpiSwiglu {
    EPI_FLAGS(false, false, false, false)
    bf16_t* uo;
    __device__ __forceinline__ void operator()(Acc& acc, const Unit& u, int wr, int wc, int fr, int fq) const {
        FOR_AI_M { const size_t R = (size_t)u.pm * 256 + 128 * ai + 64 * wr + 16 * m + fr;
            const f32x4 g0 = acc[ai][0][m][0], g1 = acc[ai][0][m][1];
            store8(uo + R * DFF + u.pn * 128 + 32 * wc + 8 * fq, g0 * sig4(g0) * acc[ai][1][m][0], g1 * sig4(g1) * acc[ai][1][m][1]); }
    }
};

struct Sched2D {
    pg8::Order2D o; const char* A; const char* B; size_t sa, sb;
    __device__ bool next(int i, Unit& u) const { int pm, pn; if (!o.get(i, pm, pn)) return false; u.A = A + (size_t)pm * sa; u.B = B + (size_t)pn * sb; u.pm = pm; u.pn = pn; u.f = 1; u.sc = 0.f; return true; }
};
struct SchedSlots {
    int G, c, nslots, nch, mode; const char* A; const char* B;
    __device__ bool next(int i, Unit& u) const {
        const int slot = i * G + c; if (slot >= nslots) return false;
        const int bl = slot / (8 * nch), head = (slot / nch) & 7, ch = slot % nch, rowtile = bl * nch + ch;
        if (mode == 0) { u.A = A + (size_t)slot * SLOTB + 256 * 2; u.B = B + ((size_t)rowtile * 256 * 1024 + head * 128) * 2; }
        else { u.A = A + (size_t)slot * SLOTB; u.B = B + (size_t)slot * SLOTB; }
        u.pm = slot; u.pn = head; u.f = rowtile; u.sc = 0.f; return true;
    }
};
struct SchedChain {
    int G, c, b0; const char *cbb, *ckt, *bbuf, *kt; const float* l2g;
    __device__ bool next(int i, Unit& u) const {
        const int ch = c + (i >> 3) * G, step = i & 7; if (ch >= 128) return false;
        const int bl = ch >> 4, head = (ch >> 1) & 7, dir = ch & 1;
        const size_t dirb = (size_t)dir * 64 * KTROWS * 256 * 2, hb_ = (size_t)head * 128 * 256 * 2;
        if (step == 0) {
            u.A = cbb + (size_t)((b0 + bl) * 8 + head) * SLOTB; u.B = ckt + dirb + (size_t)(b0 + bl) * KTROWS * 256 * 2 + hb_;
            u.pm = (bl * 8 + head) * 8 + (dir ? 7 : 0);
        } else {
            const int cc = dir ? 8 - step : step - 1;
            u.A = bbuf + (size_t)((bl * 8 + head) * 8 + cc) * SLOTB; u.B = kt + dirb + (size_t)(bl * 8 + cc) * KTROWS * 256 * 2 + hb_;
            u.pm = (bl * 8 + head) * 8 + (dir ? cc - 1 : cc + 1);
        }
        u.pn = dir ? 384 : 256; u.f = (step == 0); u.sc = exp2f(256.0f * l2g[dir * 8 + head]);
        return true;
    }
};

struct Args { const float* in[17]; float* out; unsigned char* ws; };
enum { I_X = 0, I_C, I_CTX, I_CCTX, I_NMW, I_ADAW, I_ADAB, I_WIN, I_DECAY, I_CONVW, I_WRO, I_WCO, I_WO, I_NFW, I_WFI, I_WFO, I_FNW };

__device__ __forceinline__ void norm_mod_phase(const float* x, int nrows, const float* nw, const float* mod, int b0, int ctx, int sidx, bf16_t* dst) {
    int lane_ = threadIdx.x & 63; asm volatile("" : "+v"(lane_)); const int lane = lane_, gw = blockIdx.x * 8 + __builtin_amdgcn_readfirstlane(threadIdx.x >> 6), stride = gridDim.x * 8;
    for (int pr = gw; pr < nrows / 2; pr += stride) {
        const int row = 2 * pr;
        const float* sh = mod + (size_t)(ctx ? 32 : b0 + (row >> 11)) * 6144 + sidx * 1024; const float* sc = sh + 1024;
        const float* xr = x + (size_t)row * 1024;
        f32x4 v[4], u[4]; float ss = 0.f, st = 0.f;
#pragma unroll
        for (int q = 0; q < 4; ++q) { v[q] = *(const GAS f32x4*)(xr + q * 256 + lane * 4); u[q] = *(const GAS f32x4*)(xr + 1024 + q * 256 + lane * 4); }
#pragma unroll
        for (int q = 0; q < 4; ++q) { ss += v[q][0] * v[q][0] + v[q][1] * v[q][1] + v[q][2] * v[q][2] + v[q][3] * v[q][3]; st += u[q][0] * u[q][0] + u[q][1] * u[q][1] + u[q][2] * u[q][2] + u[q][3] * u[q][3]; }
#pragma unroll
        for (int o = 32; o > 0; o >>= 1) { ss += __shfl_xor(ss, o); st += __shfl_xor(st, o); }
        const float rs = rsqrtf(ss * (1.0f / 1024.0f) + EPS), rt = rsqrtf(st * (1.0f / 1024.0f) + EPS);
#pragma unroll
        for (int q = 0; q < 4; ++q) { const int c = q * 256 + lane * 4;
            const f32x4 w4 = *(const GAS f32x4*)(nw + c), s4 = *(const GAS f32x4*)(sc + c) + 1.0f, h4 = *(const GAS f32x4*)(sh + c);
            store4(dst + (size_t)row * 1024 + c, (v[q] * rs * w4) * s4 + h4);
            store4(dst + (size_t)(row + 1) * 1024 + c, (u[q] * rt * w4) * s4 + h4); }
    }
}
__device__ __forceinline__ void conv_phase(bf16_t* xbuf, const float* convw, int nrows, int seqmask, int wg0, int nwg, bf16_t* dbase, int dpitch) {
    int lane_ = threadIdx.x & 63; asm volatile("" : "+v"(lane_)); const int lane = lane_, gw = ((int)blockIdx.x - wg0) * 8 + __builtin_amdgcn_readfirstlane(threadIdx.x >> 6), stride = nwg * 8;
    for (int pr = gw; pr < nrows / 2; pr += stride) {
        const int row = 2 * pr, t = row & seqmask;
        const bf16_t* cr = xbuf + (size_t)row * XLD + 2048 + lane * 8;
        u32x4 cbA[2], cbB[2], wP[2], wA[2], wB[2], wN[2];
        const bool hp = t > 0, hn = t + 1 < seqmask;
#pragma unroll
        for (int q = 0; q < 2; ++q) {
            cbA[q] = *(const GAS u32x4*)(cr + q * 512); cbB[q] = *(const GAS u32x4*)(cr + XLD + q * 512);
            wA[q] = *(const GAS u32x4*)(cr + 1024 + q * 512); wB[q] = *(const GAS u32x4*)(cr + XLD + 1024 + q * 512);
            wP[q] = (u32x4){0u, 0u, 0u, 0u}; wN[q] = wP[q];
            if (hp) wP[q] = *(const GAS u32x4*)(cr - XLD + 1024 + q * 512);
            if (hn) wN[q] = *(const GAS u32x4*)(cr + 2 * XLD + 1024 + q * 512);
        }
#pragma unroll
        for (int q = 0; q < 2; ++q) { const float* wp = convw + q * 512 + lane * 8;
            const f32x4 w00 = *(const GAS f32x4*)(wp), w01 = *(const GAS f32x4*)(wp + 4), w10 = *(const GAS f32x4*)(wp + 1024), w11 = *(const GAS f32x4*)(wp + 1028), w20 = *(const GAS f32x4*)(wp + 2048), w21 = *(const GAS f32x4*)(wp + 2052);
            f32x4 p0, p1, x0, x1, y0, y1, n0, n1, c0, c1, d0, d1;
            unpack8(wP[q], p0, p1); unpack8(wA[q], x0, x1); unpack8(wB[q], y0, y1); unpack8(wN[q], n0, n1);
            unpack8(cbA[q], c0, c1); unpack8(cbB[q], d0, d1);
            bf16_t* dr = dbase + (size_t)row * dpitch + lane * 8;
            store8(dr + q * 512, c0 * (p0 * w00 + x0 * w10 + y0 * w20), c1 * (p1 * w01 + x1 * w11 + y1 * w21));
            store8(dr + dpitch + q * 512, d0 * (x0 * w00 + y0 * w10 + n0 * w20), d1 * (x1 * w01 + y1 * w11 + n1 * w21)); }
    }
}
__device__ __forceinline__ void final_norm_phase(float* x, int nrows, const float* nw) {
    int lane_ = threadIdx.x & 63; asm volatile("" : "+v"(lane_)); const int lane = lane_, gw = blockIdx.x * 8 + __builtin_amdgcn_readfirstlane(threadIdx.x >> 6), stride = gridDim.x * 8;
    for (int qr = gw; qr < nrows / 4; qr += stride) {
        float* xr = x + (size_t)qr * 4096; f32x4 v[4][4]; float ss[4];
#pragma unroll
        for (int r = 0; r < 4; ++r)
#pragma unroll
            for (int q = 0; q < 4; ++q) v[r][q] = *(const GAS f32x4*)(xr + r * 1024 + q * 256 + lane * 4);
#pragma unroll
        for (int r = 0; r < 4; ++r) { ss[r] = 0.f;
#pragma unroll
            for (int q = 0; q < 4; ++q) ss[r] += v[r][q][0] * v[r][q][0] + v[r][q][1] * v[r][q][1] + v[r][q][2] * v[r][q][2] + v[r][q][3] * v[r][q][3]; }
#pragma unroll
        for (int o = 32; o > 0; o >>= 1) {
#pragma unroll
            for (int r = 0; r < 4; ++r) ss[r] += __shfl_xor(ss[r], o); }
#pragma unroll
        for (int q = 0; q < 4; ++q) { const int c = q * 256 + lane * 4; const f32x4 w4 = *(const GAS f32x4*)(nw + c);
#pragma unroll
            for (int r = 0; r < 4; ++r) *(GAS f32x4*)(xr + r * 1024 + c) = v[r][q] * rsqrtf(ss[r] * (1.0f / 1024.0f) + EPS) * w4; }
    }
}

__device__ __forceinline__ int lane_col(int e) { return 32 * (e >> 5) + 16 * ((e >> 2) & 1) + 4 * ((e >> 3) & 3) + (e & 3); }
__device__ __forceinline__ int rope_perm(int n) { const int head = n >> 7, d = n & 127, x2 = (d >> 5) & 1, e = 64 * (head & 1) + (d < 64 ? 0 : 32) + (d & 31); return (head >> 1) * 256 + 128 * x2 + lane_col(e); }
__device__ __forceinline__ int nat8_perm(int c) { return (c & ~127) + lane_col(c & 127); }
__device__ __forceinline__ int ccu_perm(int n) { const int cu = n >> 10, ch = n & 1023; return (ch >> 7) * 256 + 128 * cu + lane_col(ch & 127); }
__device__ __forceinline__ int swiglu_perm(int c) { const int up = c >= DFF, f = c - DFF * up, tile = f >> 7, u = f & 127; return tile * 256 + 128 * up + lane_col(u); }
struct ConvJob { const float* src; int ldsrc, K, c0, ncol; bf16_t* dst; int lddst, dcol0, row0, perm; float scale; };
__device__ __forceinline__ void convert_job(const ConvJob& J, float* tl  ) {
    const int tid = threadIdx.x, nkt = J.K / 128, nnt = J.ncol / 128, ntile = nkt * nnt;
    for (int tile = blockIdx.x; tile < ntile; tile += gridDim.x) {
        const int k0 = (tile % nkt) * 128, n0 = (tile / nkt) * 128;
        { const int tx = tid & 127, ty = tid >> 7;
          float v[32];
#pragma unroll
          for (int p = 0; p < 32; ++p) v[p] = J.src[(size_t)(k0 + ty + 4 * p) * J.ldsrc + J.c0 + n0 + tx];
#pragma unroll
          for (int p = 0; p < 32; ++p) tl[(ty + 4 * p) * 129 + tx] = v[p]; }
        __syncthreads();
#pragma unroll
        for (int h = 0; h < 4; ++h) {
          const int n = (tid >> 4) + 32 * h, kq = tid & 15; const int nl = n0 + n;
          const int prow = J.perm == 1 ? rope_perm(nl) : (J.perm == 2 ? swiglu_perm(nl) : (J.perm == 3 ? nat8_perm(nl) : (J.perm == 5 ? ccu_perm(nl) : nl)));
          u32x4 w; float v[8];
#pragma unroll
          for (int jj = 0; jj < 8; ++jj) v[jj] = tl[(kq * 8 + jj) * 129 + n] * J.scale;
          w.x = cvtpk(v[0], v[1]); w.y = cvtpk(v[2], v[3]); w.z = cvtpk(v[4], v[5]); w.w = cvtpk(v[6], v[7]);
          *(GAS u32x4*)(J.dst + (size_t)(J.row0 + prow) * J.lddst + J.dcol0 + k0 + kq * 8) = w; }
        __syncthreads();
    }
}

__device__ __forceinline__ void e1_phase(const Args& a, unsigned char* ws0, int l, int g) {
    unsigned char* ws = lw(ws0);
    const int ctx = g < 0;
    const float* xin = ctx ? (l == 0 ? a.in[I_CTX] : (const float*)(ws + WS_XC)) : ((l == 0 ? a.in[I_X] : (const float*)a.out) + (size_t)g * MG * 1024);
    norm_mod_phase(xin, ctx ? MC : MG, a.in[I_NMW] + l * 1024, (const float*)(ws + WS_MOD) + (size_t)l * 33 * 6144, ctx ? 0 : g * GB, ctx, 0, (bf16_t*)(ws + WS_H));
}
#ifndef PHM
#define PHM 0xFFFF
#endif
#ifndef DUPM
#define DUPM 0
#endif
#define REP(bit) for (int rep_ = 0; rep_ <= ((DUPM >> (bit)) & 1); ++rep_)
__global__ void __launch_bounds__(512, 2) mega_fwd(Args a) {
    extern __shared__ __attribute__((aligned(16))) unsigned char lds_raw[];
    LAS unsigned char* lds = (LAS unsigned char*)lds_raw;
    cg::grid_group grid = cg::this_grid();
    unsigned char* ws = a.ws;
    const int G = gridDim.x, cid = blockIdx.x, tid = threadIdx.x;
    float* sc = (float*)(ws + WS_SC); float* l2g_all = (float*)(ws + WS_L2G);
    float* cosT_ = (float*)(ws + WS_ROPE); float* sinT_ = cosT_ + 2048; float* cosT2_ = cosT_ + 4096; float* sinT2_ = cosT_ + 6144;
    float* mod_all = (float*)(ws + WS_MOD);

    {
        const int gt = cid * 512 + tid, gs = G * 512;
        if (cid == 0) { unsigned* bw = (unsigned*)(ws + WS_BAR); for (int i = tid; i < XCD_BAR_WORDS; i += 512) bw[i] = 0u; }
        if (cid == 1) { float* zv = (float*)(ws + WS_ZERO); for (int i = tid; i < 1024; i += 512) zv[i] = 0.f; }
        for (int i = gt; i < 33 * 1024; i += gs) { const float v = (i < 32 * 1024) ? a.in[I_C][i] : a.in[I_CCTX][i - 32 * 1024]; sc[i] = v / (1.0f + expf(-v)); }
        if (gt < 32) { const float xl = a.in[I_DECAY][gt]; l2g_all[gt] = -log1pf(expf(-xl)) * 1.4426950408889634f; }
        for (int i = gt; i < 2048; i += gs) { const int pos = i >> 5, fi = i & 31; const float fr_ = exp2f(-(float)fi * (13.287712379549449f / 32.0f)); const float ang = (float)pos * fr_;
            const float c = cosf(ang), s = sinf(ang); cosT_[pos * 32 + fi] = c; sinT_[pos * 32 + fi] = s; cosT2_[fi * 64 + pos] = c; sinT2_[fi * 64 + pos] = s; }
        float* tl = (float*)lds_raw;
        REP(8) for (int l = 0; l < 2; ++l) {
            bf16_t* wnat = (bf16_t*)(ws + WS_WNAT) + (size_t)l * NNAT * 1024;
            const float* win = a.in[I_WIN] + (size_t)l * 1024 * 11264;
            const float ks = 0.08838834764831845f;
            const ConvJob jobs[13] = {
                {win, 11264, 1024, 0, 1024, wnat, 1024, 0, 0, 1, 1.0f},
                {win, 11264, 1024, 1024, 1024, wnat, 1024, 0, 1024, 1, ks},
                {win, 11264, 1024, 1024, 1024, (bf16_t*)(ws + WS_WKN) + (size_t)l * 3072 * 1024, 1024, 0, 0, 0, ks},
                {win, 11264, 1024, 2048, 2048, (bf16_t*)(ws + WS_WKN) + (size_t)l * 3072 * 1024, 1024, 0, 1024, 0, 1.0f},
                {win, 11264, 1024, 4096, 2048, wnat, 1024, 0, 2048, 3, 1.0f},
                {win, 11264, 1024, 6144, 1024, wnat, 1024, 0, 4096, 3, 1.0f},
                {win, 11264, 1024, 7168, 2048, wnat, 1024, 0, 5120, 5, 1.0f},
                {win, 11264, 1024, 9216, 2048, wnat, 1024, 0, 7168, 5, 1.0f},
                {a.in[I_WRO] + (size_t)l * 2048 * 1024, 1024, 2048, 0, 1024, (bf16_t*)(ws + WS_WY) + (size_t)l * 1024 * 3072, 3072, 0, 0, 0, 1.0f},
                {a.in[I_WCO] + (size_t)l * 1024 * 1024, 1024, 1024, 0, 1024, (bf16_t*)(ws + WS_WY) + (size_t)l * 1024 * 3072, 3072, 2048, 0, 0, 1.0f},
                {a.in[I_WO] + (size_t)l * 1024 * 1024, 1024, 1024, 0, 1024, (bf16_t*)(ws + WS_WO) + (size_t)l * 1024 * 1024, 1024, 0, 0, 0, 1.0f},
                {a.in[I_WFI] + (size_t)l * 1024 * 5632, 5632, 1024, 0, 5632, (bf16_t*)(ws + WS_WFI) + (size_t)l * 5632 * 1024, 1024, 0, 0, 2, 1.0f},
                {a.in[I_WFO] + (size_t)l * DFF * 1024, 1024, DFF, 0, 1024, (bf16_t*)(ws + WS_WFO) + (size_t)l * 1024 * DFF, DFF, 0, 0, 0, 1.0f},
            };
#pragma unroll
            for (int j = 0; j < 13; ++j) convert_job(jobs[j], tl);
        }
    }
    grid.sync();
    volatile LAS unsigned* xst = (volatile LAS unsigned*)(lds + 131072);
    if (tid == 0) { xst[0] = 0u; xst[1] = 0u; }
    __syncthreads();
    const XcdBarrier xb = xcd_barrier_post((unsigned*)(ws + WS_BAR), xst);

    {
        float* red = (float*)lds_raw;
        for (int blk = cid; blk < 192; blk += G) {
            const int l = blk / 96, n0 = (blk % 96) * 64, ksl = tid >> 6, col = tid & 63;
            const float* w = a.in[I_ADAW] + (size_t)l * 1024 * 6144 + n0 + col;
            float accv[33];
#pragma unroll
            for (int b = 0; b < 33; ++b) accv[b] = 0.f;
#pragma unroll 1
            for (int k = ksl * 128; k < ksl * 128 + 128; k += 8) {
                float wv[8];
#pragma unroll
                for (int i = 0; i < 8; ++i) wv[i] = w[(size_t)(k + i) * 6144];
#pragma unroll
                for (int b = 0; b < 33; ++b) { const f32x4 s0 = *(const GAS f32x4*)(sc + b * 1024 + k), s1 = *(const GAS f32x4*)(sc + b * 1024 + k + 4);
                    accv[b] += ((s0[0] * wv[0] + s0[1] * wv[1]) + (s0[2] * wv[2] + s0[3] * wv[3])) + ((s1[0] * wv[4] + s1[1] * wv[5]) + (s1[2] * wv[6] + s1[3] * wv[7])); } }
#pragma unroll
            for (int b = 0; b < 33; ++b) red[(ksl * 33 + b) * 64 + col] = accv[b];
            __syncthreads();
            for (int i = tid; i < 33 * 64; i += 512) { float s = a.in[I_ADAB][l * 6144 + n0 + (i & 63)];
#pragma unroll
                for (int k8 = 0; k8 < 8; ++k8) s += red[k8 * 33 * 64 + i];
                mod_all[((size_t)l * 33 + (i >> 6)) * 6144 + n0 + (i & 63)] = s; }
            __syncthreads();
        }
    }
    { xcd_barrier(xb); if (DUPM & (1 << 11)) xcd_barrier(xb); }

#define P_hb ((bf16_t*)(lw(ws) + WS_H))
#define P_qb ((bf16_t*)(lw(ws) + WS_Q))
#define P_kb ((bf16_t*)(lw(ws) + WS_K))
#define P_ktb ((bf16_t*)(lw(ws) + WS_KT))
#define P_cktb ((bf16_t*)(lw(ws) + WS_CKT))
#define P_sgb ((bf16_t*)(lw(ws) + WS_SG))
#define P_convb ((bf16_t*)(lw(ws) + WS_CONV))
#define P_gatesb ((bf16_t*)(lw(ws) + WS_GATES))
#define P_abuf ((bf16_t*)(lw(ws) + WS_ABUF))
#define P_bbuf ((bf16_t*)(lw(ws) + WS_BBUF))
#define P_cbb ((bf16_t*)(lw(ws) + WS_CBB))
#define P_ob ((bf16_t*)(lw(ws) + WS_O))
#define P_yb ((bf16_t*)(lw(ws) + WS_Y))
#define P_mrgb ((bf16_t*)(lw(ws) + WS_MRG))
#define P_h2b ((bf16_t*)(lw(ws) + WS_H2))
#define P_ub ((bf16_t*)(lw(ws) + WS_U))
#define P_xc ((float*)(lw(ws) + WS_XC))
#define P_cosT ((const float*)(lw(ws) + WS_ROPE))
#define P_sinT ((const float*)(lw(ws) + WS_ROPE + 8192))
#define P_cosT2 ((const float*)(lw(ws) + WS_ROPE + 16384))
#define P_sinT2 ((const float*)(lw(ws) + WS_ROPE + 24576))
#define P_mod ((const float*)(lw(ws) + WS_MOD) + (size_t)l * 33 * 6144)
#define P_l2g ((const float*)(lw(ws) + WS_L2G) + l * 16)
#define P_wnat ((const bf16_t*)(lw(ws) + WS_WNAT) + (size_t)l * NNAT * 1024)
#define P_wkn ((const bf16_t*)(lw(ws) + WS_WKN) + (size_t)l * 3072 * 1024)
#define P_wy ((const bf16_t*)(lw(ws) + WS_WY) + (size_t)l * 1024 * 3072)
#define P_wo ((const bf16_t*)(lw(ws) + WS_WO) + (size_t)l * 1024 * 1024)
#define P_wfi ((const bf16_t*)(lw(ws) + WS_WFI) + (size_t)l * 5632 * 1024)
#define P_wfo ((const bf16_t*)(lw(ws) + WS_WFO) + (size_t)l * 1024 * DFF)
#define AIN(i) ((const float*)lw((unsigned char*)a.in[i]))
#define P_nmw (AIN(I_NMW) + l * 1024)
#define P_nfw (AIN(I_NFW) + l * 1024)
#define P_convw (AIN(I_CONVW) + (size_t)l * 3 * 1024)
#define AOUT ((float*)lw((unsigned char*)a.out))

    bool e1_pending = true;
    for (int l = 0; l < 2; ++l) {
        for (int g = -1; g < NGROUP; ++g) {
            const int ctx = g < 0;
            const int nrows = ctx ? MC : MG, nrt = nrows / 256, nch = ctx ? 1 : 8, b0 = ctx ? 0 : g * GB;
            const bool full = !(ctx && l == 1);
            #define P_xin0 (ctx ? (l == 0 ? AIN(I_CTX) : P_xc) : ((l == 0 ? AIN(I_X) : AOUT) + (size_t)g * MG * 1024))
#define P_xres (ctx ? P_xc : AOUT + (size_t)g * MG * 1024)

            if (e1_pending) { e1_phase(a, ws, l, g); { xcd_barrier(xb); if (DUPM & (1 << 11)) xcd_barrier(xb); } }
            e1_pending = true;
            REP(1) {
            if (full) {
                Sched2D S; S.o.init(nrt, NNAT / 256, G, cid); S.A = (const char*)P_hb; S.B = (const char*)P_wnat; S.sa = S.sb = (size_t)256 * 1024 * 2;
                EpiNat E; E.mid_t = -1; E.q = P_qb; E.sg = P_sgb; E.abuf = P_abuf; E.kft = ctx ? P_cktb : P_ktb; E.cosT = P_cosT; E.sinT = P_sinT; E.l2g = P_l2g; E.nch = nch; E.rope = !ctx;
                if (PHM & (1 << 0)) pg8::gemm_phase(lds, 1024, 1024, 1024, S, E);
            }
            {
                if (full) {
                    Sched2D S; S.o.init(8, nrt, G, cid); S.A = (const char*)(P_wkn + (size_t)1024 * 1024); S.B = (const char*)P_hb; S.sa = S.sb = (size_t)256 * 1024 * 2;
                    EpiVT E; E.mid_t = -1; E.bbuf = ctx ? P_cbb : P_bbuf; E.nch = nch;
                    if (PHM & (1 << 1)) pg8::gemm_phase(lds, 1024, 1024, 1024, S, E);
                } else {
                Sched2D S; S.o.init(12, nrt, G, cid); S.A = (const char*)P_wkn; S.B = (const char*)P_hb; S.sa = S.sb = (size_t)256 * 1024 * 2;
                EpiKV E; E.mid_t = -1; E.kt.kft = ctx ? P_cktb : P_ktb; E.kt.kbt = E.kt.kft + (size_t)64 * KTROWS * 256; E.kt.cosT = P_cosT; E.kt.sinT = P_sinT; E.kt.cosT2 = P_cosT2; E.kt.sinT2 = P_sinT2; E.kt.l2g = P_l2g; E.kt.rope = !ctx;
                E.vt.bbuf = ctx ? P_cbb : P_bbuf; E.vt.nch = nch;
                if (PHM & (1 << 1)) pg8::gemm_phase(lds, 1024, 1024, 1024, S, E);
                }
            }
            { xcd_barrier(xb); if (DUPM & (1 << 11)) xcd_barrier(xb); } }
            if (!full) continue;
            REP(2) {
                const int half = ctx ? 0 : G / 2;
                if (cid >= half) {
                    SchedSlots S; S.G = G - half; S.c = cid - half; S.nslots = nrt * 8; S.nch = nch; S.mode = 0; S.A = (const char*)P_abuf; S.B = (const char*)P_kb;
                    EpiScores E; E.mid_t = -1; E.abuf = P_abuf; E.l2g = P_l2g;
                    int k128 = 128; asm volatile("" : "+s"(k128));
                    if (PHM & (1 << 3)) pg8::gemm_phase(lds, 512, 1024, k128, S, E);
                    if (rep_ == 0) conv_phase(P_sgb, P_convw, nrows, ctx ? 255 : 2047, half, G - half, P_sgb + 2048, XLD);
                    else if (DUPM & (1 << 12)) conv_phase(P_sgb, P_convw, nrows, ctx ? 255 : 2047, half, G - half, P_hb, 1024);
                } else {
                    SchedChain S; S.G = half; S.c = cid; S.b0 = b0; S.cbb = (const char*)P_cbb; S.ckt = (const char*)P_cktb; S.bbuf = (const char*)P_bbuf; S.kt = (const char*)P_ktb; S.l2g = P_l2g;
                    EpiChain E; E.mid_t = -1; E.bbuf = P_bbuf;
                    if (PHM & (1 << 4)) pg8::gemm_phase(lds, 512, 256, 256, S, E);
                }
            { xcd_barrier(xb); if (DUPM & (1 << 11)) xcd_barrier(xb); } }
            REP(3) {
                SchedSlots S; S.G = G; S.c = cid; S.nslots = nrt * 8; S.nch = nch; S.mode = 1; S.A = (const char*)P_abuf; S.B = (const char*)(ctx ? P_cbb : P_bbuf);
                EpiO E; E.mid_t = -1; E.xb = P_sgb; E.xl = lds + 131072 + 256; E.ob = rep_ == 0 ? P_sgb : P_hb; E.opitch = rep_ == 0 ? XLD : 2048;
                if (PHM & (1 << 5)) pg8::gemm_phase(lds, 512, 512, ctx ? 256 : 512, S, E);
            { xcd_barrier(xb); if (DUPM & (1 << 11)) xcd_barrier(xb); } }
            REP(5) {
                Sched2D S; S.o.init(nrt, 4, G, cid); S.A = (const char*)P_sgb; S.B = (const char*)P_wy; S.sa = (size_t)256 * XLD * 2; S.sb = (size_t)256 * 3072 * 2;
                EpiMerge E; E.mid_t = 32; E.gates = P_gatesb; E.mrg = P_mrgb;
                if (PHM & (1 << 6)) pg8::gemm_phase(lds, XLD, 3072, 3072, S, E);
            { xcd_barrier(xb); if (DUPM & (1 << 11)) xcd_barrier(xb); } }
            {
                Sched2D S; S.o.init(nrt, 4, G, cid); S.A = (const char*)P_mrgb; S.B = (const char*)P_wo; S.sa = S.sb = (size_t)256 * 1024 * 2;
                EpiRes E; E.mid_t = -1; E.xin = P_xin0; E.xout = P_xres; E.mod = P_mod; E.b0 = b0; E.ctx = ctx; E.which = 2; E.zero = nullptr;
                if (PHM & (1 << 7)) pg8::gemm_phase(lds, 1024, 1024, 1024, S, E);
            }
            { xcd_barrier(xb); if (DUPM & (1 << 11)) xcd_barrier(xb); }
            if (DUPM & (1 << 9)) {
                Sched2D S; S.o.init(nrt, 4, G, cid); S.A = (const char*)P_mrgb; S.B = (const char*)P_wo; S.sa = S.sb = (size_t)256 * 1024 * 2;
                EpiRes E; E.mid_t = -1; E.xin = P_xres; E.xout = P_xres; E.mod = P_mod; E.b0 = b0; E.ctx = ctx; E.which = 2; E.zero = (const float*)(lw(ws) + WS_ZERO);
                pg8::gemm_phase(lds, 1024, 1024, 1024, S, E);
                { xcd_barrier(xb); if (DUPM & (1 << 11)) xcd_barrier(xb); }
            }
            REP(6) { norm_mod_phase(P_xres, nrows, P_nfw, P_mod, b0, ctx, 3, P_h2b);
            { xcd_barrier(xb); if (DUPM & (1 << 11)) xcd_barrier(xb); } }
            REP(7) {
                Sched2D S; S.o.init(nrt, 22, G, cid); S.A = (const char*)P_h2b; S.B = (const char*)P_wfi; S.sa = S.sb = (size_t)256 * 1024 * 2;
                EpiSwiglu E; E.mid_t = -1; E.uo = P_ub;
                if (PHM & (1 << 8)) pg8::gemm_phase(lds, 1024, 1024, 1024, S, E);
            { xcd_barrier(xb); if (DUPM & (1 << 11)) xcd_barrier(xb); } }
            {
                Sched2D S; S.o.init(nrt, 4, G, cid); S.A = (const char*)P_ub; S.B = (const char*)P_wfo; S.sa = S.sb = (size_t)256 * DFF * 2;
                EpiRes E; E.mid_t = -1; E.xin = P_xres; E.xout = P_xres; E.mod = P_mod; E.b0 = b0; E.ctx = ctx; E.which = 5; E.zero = nullptr;
                if (PHM & (1 << 9)) pg8::gemm_phase(lds, DFF, DFF, DFF, S, E);
            }
            { int g2 = g + 1, l2 = l; if (g2 == NGROUP) { g2 = -1; l2 = l + 1; }
              if (l2 < 2) { e1_phase(a, ws, l2, g2); e1_pending = false; } }
            { xcd_barrier(xb); if (DUPM & (1 << 11)) xcd_barrier(xb); }
            if (DUPM & (1 << 10)) {
                Sched2D S; S.o.init(nrt, 4, G, cid); S.A = (const char*)P_ub; S.B = (const char*)P_wfo; S.sa = S.sb = (size_t)256 * DFF * 2;
                EpiRes E; E.mid_t = -1; E.xin = P_xres; E.xout = P_xres; E.mod = P_mod; E.b0 = b0; E.ctx = ctx; E.which = 5; E.zero = (const float*)(lw(ws) + WS_ZERO);
                pg8::gemm_phase(lds, DFF, DFF, DFF, S, E);
                { xcd_barrier(xb); if (DUPM & (1 << 11)) xcd_barrier(xb); }
            }
        }
    }
    final_norm_phase(AOUT, NB * T, AIN(I_FNW));
}

extern "C" void kernel_launch(void* const* d_in, const int* in_sizes, int n_in, void* d_out, int out_size, void* d_ws, size_t ws_size, hipStream_t stream) {
    static int grid = 0;
    if (grid == 0) {
        if (n_in != 17 || ws_size < WS_END) { fprintf(stderr, "kernel_launch: need 17 inputs and %zu bytes of workspace (got %d, %zu)\n", (size_t)WS_END, n_in, ws_size); grid = -1; return; }
        int dev = 0, cus = 0, per_cu = 0;
        hipGetDevice(&dev);
        hipDeviceGetAttribute(&cus, hipDeviceAttributeMultiprocessorCount, dev);
        if (hipFuncSetAttribute((const void*)mega_fwd, hipFuncAttributeMaxDynamicSharedMemorySize, LDS_BYTES) != hipSuccess) { fprintf(stderr, "kernel_launch: hipFuncSetAttribute failed\n"); grid = -1; return; }
        if (hipOccupancyMaxActiveBlocksPerMultiprocessor(&per_cu, (const void*)mega_fwd, 512, LDS_BYTES) != hipSuccess || per_cu < 1) { fprintf(stderr, "kernel_launch: occupancy query says %d\n", per_cu); per_cu = 1; }
        (void)hipGetLastError();
        grid = cus;
    }
    if (grid < 0) return;
    Args a{};
    for (int i = 0; i < 17; ++i) a.in[i] = (const float*)d_in[i];
    a.out = (float*)d_out; a.ws = (unsigned char*)d_ws;
    void* args[] = {&a};
    hipError_t e = hipLaunchCooperativeKernel((const void*)mega_fwd, dim3(grid), dim3(512), args, LDS_BYTES, stream);
    if (e != hipSuccess) fprintf(stderr, "cooperative launch failed: %s (grid %d)\n", hipGetErrorString(e), grid);
}
```

```cpp
#include <hip/hip_runtime.h>
#include <hip/hip_cooperative_groups.h>
#include <cstdio>
#include <cstdint>
namespace cg = cooperative_groups;

#define LAS __attribute__((address_space(3)))
#define GAS __attribute__((address_space(1)))
typedef unsigned short bf16_t;
typedef short bf16x8 __attribute__((ext_vector_type(8)));
typedef float f32x4 __attribute__((ext_vector_type(4)));
typedef float f32x2 __attribute__((ext_vector_type(2)));
typedef unsigned u32x2 __attribute__((ext_vector_type(2)));
typedef unsigned u32x4 __attribute__((ext_vector_type(4)));
typedef __bf16 bf16x2_t __attribute__((ext_vector_type(2)));

constexpr int D = 1024, NB = 32, T = 2048, TC = 256, NH = 8, DFF = 2816;
constexpr int GB = 8, MG = GB * T, NGROUP = NB / GB, MC = NB * TC;
constexpr int NNAT = 9216;
constexpr int KTLD = 16384, KTROWS = 1152;
constexpr float EPS = 1e-6f;

constexpr size_t WS_SC = 0;
constexpr size_t WS_L2G = WS_SC + 33 * 1024 * 4;
constexpr size_t WS_BAR = WS_L2G + 4096;
constexpr size_t WS_ZERO = WS_BAR + 16384;
constexpr size_t WS_ROPE = WS_ZERO + 4096;
constexpr size_t WS_MOD = WS_ROPE + 4 * 8192;
constexpr size_t WS_WNAT = (WS_MOD + 2 * 33 * 6144 * 4 + 4095) & ~size_t(4095);
constexpr size_t WS_WKN = WS_WNAT + (size_t)2 * NNAT * 1024 * 2;
constexpr size_t WS_WY = WS_WKN + (size_t)2 * 3072 * 1024 * 2;
constexpr size_t WS_WO = WS_WY + (size_t)2 * 1024 * 3072 * 2;
constexpr size_t WS_WFI = WS_WO + (size_t)2 * 1024 * 1024 * 2;
constexpr size_t WS_WFO = WS_WFI + (size_t)2 * 5632 * 1024 * 2;
constexpr size_t WS_XC = WS_WFO + (size_t)2 * 1024 * 2816 * 2;
constexpr size_t WS_CKT = WS_XC + (size_t)MC * 1024 * 4;
constexpr size_t WS_CBB = WS_CKT + (size_t)2 * KTROWS * KTLD * 2;
constexpr size_t WS_H = WS_CBB + (size_t)256 * 256 * 512 * 2;
constexpr size_t WS_Q = WS_H + (size_t)MG * 1024 * 2;
constexpr size_t WS_K = WS_Q + (size_t)MG * 1024 * 2;
constexpr size_t WS_KT = WS_K + (size_t)MG * 1024 * 2;
constexpr size_t WS_SG = WS_KT + (size_t)2 * KTROWS * KTLD * 2;
constexpr size_t WS_CONV = WS_SG + (size_t)MG * 2048 * 2;
constexpr size_t WS_GATES = WS_CONV + (size_t)MG * 3072 * 2;
constexpr size_t WS_ABUF = WS_GATES + (size_t)MG * 2048 * 2;
constexpr size_t WS_BBUF = WS_ABUF + (size_t)512 * 256 * 512 * 2;
constexpr size_t WS_END = WS_BBUF + (size_t)512 * 256 * 512 * 2;
constexpr size_t WS_O = WS_H;
constexpr size_t WS_Y = WS_ABUF;
constexpr size_t WS_MRG = WS_BBUF;
constexpr size_t WS_H2 = WS_BBUF + (size_t)MG * 1024 * 2;
constexpr size_t WS_U = WS_SG;
constexpr size_t SLOTB = (size_t)256 * 512 * 2;

constexpr int LDS_BYTES = 143360;
constexpr int XLD = 5120;

__device__ __forceinline__ unsigned cvtpk(float lo, float hi) { f32x2 v = {lo, hi}; bf16x2_t b = __builtin_convertvector(v, bf16x2_t); return __builtin_bit_cast(unsigned, b); }
__device__ __forceinline__ void store4(bf16_t* p, f32x4 v) { u32x2 w; w.x = cvtpk(v[0], v[1]); w.y = cvtpk(v[2], v[3]); *(GAS u32x2*)p = w; }
__device__ __forceinline__ f32x4 load4(const bf16_t* p) { const u32x2 w = *(const GAS u32x2*)p; f32x4 v; v[0] = __uint_as_float(w.x << 16); v[1] = __uint_as_float(w.x & 0xffff0000u); v[2] = __uint_as_float(w.y << 16); v[3] = __uint_as_float(w.y & 0xffff0000u); return v; }
__device__ __forceinline__ float sigmoidf_(float x) { return __builtin_amdgcn_rcpf(1.0f + __builtin_amdgcn_exp2f(x * -1.4426950408889634f)); }
__device__ __forceinline__ unsigned char* lw(unsigned char* p) { asm volatile("" : "+s"(p));
#if defined(__HIP_DEVICE_COMPILE__)
    __builtin_assume(!__builtin_amdgcn_is_shared(p)); __builtin_assume(!__builtin_amdgcn_is_private(p));
#endif
    return p; }
__device__ __forceinline__ float wave_sum(float v) {
#pragma unroll
    for (int o = 32; o > 0; o >>= 1) v += __shfl_xor(v, o);
    return v;
}


#define XB_TMO      128
#define XB_XCNT(j)  (256  + 64 * (j))
#define XB_XSUB(j)  (1280 + 64 * (j))
#define XB_XGEN(j)  (2304 + 64 * (j))
#define XB_TOP      3328
#define XB_TOPGEN   3392
#define XCD_BAR_WORDS 3456
#define XB_SPIN_CAP (1u << 22)
__device__ __forceinline__ unsigned xb_ld(unsigned* p)              { return __hip_atomic_load(p, __ATOMIC_RELAXED, __HIP_MEMORY_SCOPE_AGENT); }
__device__ __forceinline__ unsigned xb_add(unsigned* p, unsigned v) { return __hip_atomic_fetch_add(p, v, __ATOMIC_RELAXED, __HIP_MEMORY_SCOPE_AGENT); }
__device__ __forceinline__ unsigned xb_xcc_id() { return (unsigned)__builtin_amdgcn_s_getreg((3 << 11) | 20) & 0xFu; }
#define XB_SPIN(cond, bar) do { unsigned _sp = 0; while (cond) { __builtin_amdgcn_s_sleep(1); \
    if ((++_sp & 255u) == 0u) { if (xb_ld(&(bar)[XB_TMO])) break; if (_sp > XB_SPIN_CAP) { atomicAdd(&(bar)[XB_TMO], 1u); break; } } } } while (0)
struct XcdBarrier { unsigned* bar; unsigned x; volatile LAS unsigned* st; };
__device__ __forceinline__ XcdBarrier xcd_barrier_post(unsigned* bar, volatile LAS unsigned* st) {
    XcdBarrier b; b.bar = bar; b.x = xb_xcc_id(); b.st = st;
    if (threadIdx.x == 0) (void)xb_add(&bar[XB_XCNT(b.x)], 1u);
    return b;
}
__device__ __forceinline__ void xcd_barrier_complete(unsigned* bar, unsigned x, unsigned& nloc, unsigned& nx) {
    const unsigned G = gridDim.x * gridDim.y * gridDim.z;
    unsigned sum, cnt, mine, sp = 0u;
    for (;;) {
        sum = 0u; cnt = 0u; mine = 0u;
#pragma unroll
        for (unsigned j = 0; j < 16; ++j) { const unsigned c = xb_ld(&bar[XB_XCNT(j)]); sum += c; cnt += (c > 0u) ? 1u : 0u; mine = (j == x) ? c : mine; }
        if (sum == G) break;
        __builtin_amdgcn_s_sleep(1);
        if ((++sp & 255u) == 0u) { if (xb_ld(&bar[XB_TMO])) break; if (sp > XB_SPIN_CAP) { atomicAdd(&bar[XB_TMO], 1u); break; } }
    }
    nloc = mine > 0u ? mine : 1u; nx = cnt > 0u ? cnt : 1u;
}
__device__ __forceinline__ void xcd_barrier(const XcdBarrier& b) {
    asm volatile("s_waitcnt vmcnt(0)" ::: "memory");
    __syncthreads();
    if (threadIdx.x == 0) {
        unsigned* bar = b.bar; unsigned bx = b.x; asm volatile("" : "+s"(bar), "+s"(bx));
        __builtin_amdgcn_s_waitcnt(0);
        unsigned nloc = b.st[0], nx = b.st[1];
        if (nloc == 0u) { xcd_barrier_complete(bar, bx, nloc, nx); b.st[0] = nloc; b.st[1] = nx; }
        const unsigned old = xb_add(&bar[XB_XSUB(bx)], 1u);
        const unsigned gen = old / nloc;
        if (old + 1u == (gen + 1u) * nloc) {
            __builtin_amdgcn_fence(__ATOMIC_RELEASE, "agent");
            asm volatile("s_waitcnt vmcnt(0)" ::: "memory");
            const unsigned og = xb_add(&bar[XB_TOP], 1u);
            const unsigned tg = og / nx;
            if (og + 1u == (tg + 1u) * nx) xb_add(&bar[XB_TOPGEN], 1u);
            else XB_SPIN(xb_ld(&bar[XB_TOPGEN]) == tg, bar);
            __builtin_amdgcn_fence(__ATOMIC_ACQUIRE, "agent");
            xb_add(&bar[XB_XGEN(bx)], 1u);
            asm volatile("s_waitcnt vmcnt(0)" ::: "memory");
        } else {
            XB_SPIN(xb_ld(&bar[XB_XGEN(bx)]) == gen, bar);
            __builtin_amdgcn_fence(__ATOMIC_ACQUIRE, "agent");
            asm volatile("s_waitcnt vmcnt(0)" ::: "memory");
        }
    }
    __syncthreads();
}

namespace pg8 {
constexpr int BM = 256, BK = 64, HALF = 128, HTB = HALF * BK * 2;
__device__ __forceinline__ int lds_byte(int r, int c) { const int st = (r >> 4) * 2 + (c >> 5), rr = r & 15, cc = c & 31, ob = rr * 64 + cc * 2; return st * 1024 + (ob ^ (((ob >> 9) & 1) << 5)); }
__device__ __forceinline__ void stage_rc(int b, int& R, int& C) { const int st = b / 1024, sb = b % 1024, swz = sb ^ (((sb >> 9) & 1) << 5); R = (st >> 1) * 16 + swz / 64; C = (st & 1) * 32 + (swz % 64) / 2; }

struct Unit { const char* A; const char* B; int pm, pn, f; float sc; };
typedef f32x4 Acc[2][2][4][2];

struct Order2D {
    int nM, nN, nwg, G, c;
    __device__ void init(int nM_, int nN_, int G_, int c_) { nM = nM_; nN = nN_; nwg = nM * nN; G = G_; c = c_; }
    __device__ bool get(int i, int& pm, int& pn) const {
        const long L = (long)i * G + c; if (L >= nwg) return false;
        int wgid = (int)L; { const int q = nwg / 8, r = nwg % 8, xcd = wgid % 8, off = wgid / 8; wgid = (xcd < r ? xcd * (q + 1) : r * (q + 1) + (xcd - r) * q) + off; }
        const int nig = 8 * nN, gid = wgid / nig, fm = gid * 8, gsz = (nM - fm) < 8 ? (nM - fm) : 8;
        pm = fm + ((wgid % nig) % gsz); pn = (wgid % nig) / gsz; return true;
    }
};

template <class Epi, class Sched>
__device__ __forceinline__ void gemm_phase(LAS unsigned char* lds, const int lda, const int ldb, const int K, const Sched& S, const Epi& E) {
    int tid_ = threadIdx.x; asm volatile("" : "+v"(tid_));
    const int tid = tid_, wid = __builtin_amdgcn_readfirstlane(tid >> 6), lane = tid & 63, wr = wid >> 2, wc = wid & 3, fr = lane & 15, fq = lane >> 4;
    const int nt = K / BK;
    unsigned voffA[2], voffB[2];
#pragma unroll
    for (int i = 0; i < 2; ++i) { int R, C; stage_rc(tid * 16 + i * 8192, R, C); const int rho = R & 31; const int Rb = Epi::PERM ? ((R & ~31) + 8 * ((rho & 15) >> 2) + 4 * (rho >> 4) + (rho & 3)) : R;
        voffA[i] = (unsigned)(R * lda + C) * 2u; voffB[i] = (unsigned)(Rb * ldb + C) * 2u; }
    const size_t kstep = (size_t)(BK * 2);
    const size_t hstepA = (size_t)HALF * lda * 2, hstepB = (size_t)HALF * ldb * 2;
    const unsigned ldsw = (unsigned)wid * 1024u;
    const int aoff = lds_byte(wr * 64 + fr, fq * 8), boff = lds_byte(wc * 32 + fr, fq * 8);
#define PG8_SA(b, h) (((b) * 2 + (h)) * HTB)
#define PG8_SB(b, h) ((4 + (b) * 2 + (h)) * HTB)
#define PG8_STAGE(bufoff, gbase, voff) do { _Pragma("unroll") for (int _i = 0; _i < 2; ++_i) \
        __builtin_amdgcn_global_load_lds((const unsigned*)((const char*)(gbase) + (voff)[_i]), (LAS unsigned*)(lds + (bufoff) + ldsw + _i * 8192), 16, 0, 0); } while (0)
#define PG8_LDA(dst, b, h) do { _Pragma("unroll") for (int m = 0; m < 4; ++m) _Pragma("unroll") for (int k = 0; k < 2; ++k) dst[m][k] = *(const LAS bf16x8*)(lds + PG8_SA(b, h) + aoff + m * 2048 + k * 1024); } while (0)
#define PG8_LDB(dst, b, h) do { _Pragma("unroll") for (int n = 0; n < 2; ++n) _Pragma("unroll") for (int k = 0; k < 2; ++k) dst[n][k] = *(const LAS bf16x8*)(lds + PG8_SB(b, h) + boff + n * 2048 + k * 1024); } while (0)
#define PG8_MMA(ai, bj, At, Bt) do { __builtin_amdgcn_s_setprio(1); _Pragma("unroll") for (int m = 0; m < 4; ++m) _Pragma("unroll") for (int n = 0; n < 2; ++n) _Pragma("unroll") for (int k = 0; k < 2; ++k) \
        acc[ai][bj][m][n] = __builtin_amdgcn_mfma_f32_16x16x32_bf16(Bt[n][k], At[m][k], acc[ai][bj][m][n], 0, 0, 0); __builtin_amdgcn_s_setprio(0); } while (0)
#define PG8_MMA1(ai, At) do { if constexpr (!Epi::HALF_N) PG8_MMA(ai, 1, At, B1); } while (0)
#define PG8_WAIT_V(n) asm volatile("s_waitcnt vmcnt(" #n ")" ::: "memory")
#define PG8_WAIT_L(n) asm volatile("s_waitcnt lgkmcnt(" #n ")" ::: "memory")
#define PG8_BAR __builtin_amdgcn_s_barrier()
#define PG8_SCHED __builtin_amdgcn_sched_barrier(0)
    Unit cur, nxt; int ui = 0;
    if (!S.next(0, cur)) return;
    Acc acc;
#pragma unroll
    for (int a = 0; a < 2; ++a)
#pragma unroll
        for (int b = 0; b < 2; ++b)
#pragma unroll
            for (int m = 0; m < 4; ++m)
#pragma unroll
                for (int n = 0; n < 2; ++n) acc[a][b][m][n] = (f32x4){0.f, 0.f, 0.f, 0.f};
    bf16x8 At[4][2], B0[2][2], B1[2][2];
    const char* cA = cur.A; const char* cB = cur.B;
#define PG8_STAGE_B1(bufoff, gbase) do { if constexpr (!Epi::HALF_N) PG8_STAGE(bufoff, gbase, voffB); } while (0)
#define PG8_LDB1(dst, b) do { if constexpr (!Epi::HALF_N) PG8_LDB(dst, b, 1); } while (0)
#define PG8_WAIT_VL do { if constexpr (Epi::HALF_N) PG8_WAIT_V(6); else PG8_WAIT_V(8); } while (0)
    PG8_STAGE(PG8_SB(0, 0), cB, voffB); PG8_STAGE_B1(PG8_SB(0, 1), cB + hstepB); PG8_STAGE(PG8_SA(0, 0), cA, voffA); PG8_STAGE(PG8_SA(0, 1), cA + hstepA, voffA);
    if (wr == 1) PG8_BAR;
    PG8_WAIT_V(2); PG8_BAR;
    PG8_STAGE(PG8_SB(1, 0), cB + kstep, voffB); PG8_STAGE(PG8_SA(1, 0), cA + kstep, voffA); PG8_STAGE_B1(PG8_SB(1, 1), cB + hstepB + kstep);
    if constexpr (Epi::HALF_N) PG8_WAIT_V(4); else PG8_WAIT_V(6);
    PG8_BAR;
    for (;;) {
        const bool has_next = S.next(ui + 1, nxt);
        const char* nA = has_next ? nxt.A : cA; const char* nB = has_next ? nxt.B : cB;
        for (int t = 0; t < nt; t += 2) {
            const bool last = (t == nt - 2);
            const char* a1 = cA + (size_t)(t + 1) * kstep;
            const char* a2 = last ? nA : cA + (size_t)(t + 2) * kstep; const char* b2 = last ? nB : cB + (size_t)(t + 2) * kstep;
            const char* a3 = a2 + kstep; const char* b3 = b2 + kstep;
            if constexpr (Epi::HAS_MID) { if (t == E.mid_t) { int fr2 = fr, fq2 = fq; asm volatile("" : "+v"(fr2), "+v"(fq2)); E.mid(acc, cur, wr, wc, fr2, fq2); } }
            PG8_LDB(B0, 0, 0); PG8_LDB1(B1, 0); PG8_SCHED; PG8_LDA(At, 0, 0); PG8_STAGE(PG8_SA(1, 1), a1 + hstepA, voffA);
            PG8_WAIT_VL; PG8_WAIT_L(0); PG8_BAR; PG8_MMA(0, 0, At, B0); PG8_MMA1(0, At); PG8_BAR; PG8_SCHED;
            PG8_LDA(At, 0, 1); PG8_STAGE(PG8_SB(0, 0), b2, voffB); PG8_STAGE_B1(PG8_SB(0, 1), b2 + hstepB); PG8_STAGE(PG8_SA(0, 0), a2, voffA);
            PG8_WAIT_VL; PG8_WAIT_L(0); PG8_BAR; PG8_MMA(1, 0, At, B0); PG8_MMA1(1, At); PG8_BAR; PG8_SCHED;
            PG8_LDB(B0, 1, 0); PG8_LDB1(B1, 1); PG8_SCHED; PG8_LDA(At, 1, 0); PG8_STAGE(PG8_SA(0, 1), a2 + hstepA, voffA);
            PG8_WAIT_VL; PG8_WAIT_L(0); PG8_BAR; PG8_MMA(0, 0, At, B0); PG8_MMA1(0, At); PG8_BAR; PG8_SCHED;
            PG8_LDA(At, 1, 1); PG8_STAGE(PG8_SB(1, 0), b3, voffB); PG8_STAGE_B1(PG8_SB(1, 1), b3 + hstepB); PG8_STAGE(PG8_SA(1, 0), a3, voffA);
            PG8_WAIT_VL; PG8_WAIT_L(0); PG8_BAR; PG8_MMA(1, 0, At, B0); PG8_MMA1(1, At); PG8_BAR; PG8_SCHED;
        }
        if (wr == 0) PG8_BAR;
        { int fr2 = fr, fq2 = fq; asm volatile("" : "+v"(fr2), "+v"(fq2)); E(acc, cur, wr, wc, fr2, fq2); }
        if (!has_next) break;
        if (Epi::CARRY && !(nxt.f & 1)) {
            const float s = nxt.sc;
#pragma unroll
            for (int a = 0; a < 2; ++a)
#pragma unroll
                for (int b = 0; b < 2; ++b)
#pragma unroll
                    for (int m = 0; m < 4; ++m)
#pragma unroll
                        for (int n = 0; n < 2; ++n) acc[a][b][m][n] = acc[a][b][m][n] * s;
        } else {
#pragma unroll
            for (int a = 0; a < 2; ++a)
#pragma unroll
                for (int b = 0; b < 2; ++b)
#pragma unroll
                    for (int m = 0; m < 4; ++m)
#pragma unroll
                        for (int n = 0; n < 2; ++n) acc[a][b][m][n] = (f32x4){0.f, 0.f, 0.f, 0.f};
        }
        cur = nxt; cA = nA; cB = nB; ++ui;
        if (wr == 1) PG8_BAR;
    }
    PG8_WAIT_V(0);
    PG8_BAR;
#undef PG8_SA
#undef PG8_SB
#undef PG8_STAGE
#undef PG8_LDA
#undef PG8_LDB
#undef PG8_MMA
#undef PG8_MMA1
#undef PG8_STAGE_B1
#undef PG8_LDB1
#undef PG8_WAIT_VL
#undef PG8_WAIT_V
#undef PG8_WAIT_L
#undef PG8_BAR
#undef PG8_SCHED
}
}
using pg8::Unit; using pg8::Acc;

#define EPI_FLAGS(hm_, carry_, halfn_, perm_) static constexpr bool HAS_MID = hm_, CARRY = carry_, HALF_N = halfn_, PERM = perm_; int mid_t; \
    __device__ __forceinline__ void mid(Acc&, const Unit&, int, int, int, int) const {}
#define FOR_AI_M _Pragma("unroll") for (int ai = 0; ai < 2; ++ai) _Pragma("unroll") for (int m = 0; m < 4; ++m)
#define FOR_BJ _Pragma("unroll") for (int bj = 0; bj < 2; ++bj)
__device__ __forceinline__ void store8(bf16_t* p, f32x4 a, f32x4 b) { u32x4 w; w.x = cvtpk(a[0], a[1]); w.y = cvtpk(a[2], a[3]); w.z = cvtpk(b[0], b[1]); w.w = cvtpk(b[2], b[3]); *(GAS u32x4*)p = w; }
__device__ __forceinline__ void load8(const bf16_t* p, f32x4& a, f32x4& b) { const u32x4 w = *(const GAS u32x4*)p;
    a[0] = __uint_as_float(w.x << 16); a[1] = __uint_as_float(w.x & 0xffff0000u); a[2] = __uint_as_float(w.y << 16); a[3] = __uint_as_float(w.y & 0xffff0000u);
    b[0] = __uint_as_float(w.z << 16); b[1] = __uint_as_float(w.z & 0xffff0000u); b[2] = __uint_as_float(w.w << 16); b[3] = __uint_as_float(w.w & 0xffff0000u); }
__device__ __forceinline__ f32x4 sig4(f32x4 v) { f32x4 r; r[0] = sigmoidf_(v[0]); r[1] = sigmoidf_(v[1]); r[2] = sigmoidf_(v[2]); r[3] = sigmoidf_(v[3]); return r; }

struct EpiNat {
    EPI_FLAGS(false, false, false, false)
    bf16_t *q, *sg, *abuf, *kft; const float *cosT, *sinT, *l2g; int nch, rope;
    __device__ __forceinline__ void operator()(Acc& acc, const Unit& u, int wr, int wc, int fr, int fq) const {
        const int pn = u.pn;
        if (pn < 8) {
            const bool isq = pn < 4; bf16_t* dst = q + (isq ? (size_t)0 : (size_t)MG * 1024);
            const int head = 2 * (pn & 3) + (wc >> 1), type = wc & 1, i0 = 8 * fq, dbase = (type ? 64 : 0) + i0;
            const float lf = l2g[head], lb = l2g[8 + head];
            FOR_AI_M {
                const int r = 128 * ai + 64 * wr + 16 * m + fr; const size_t R = (size_t)u.pm * 256 + r;
                f32x4 cs0 = {1.f, 1.f, 1.f, 1.f}, cs1 = cs0, sn0 = {0.f, 0.f, 0.f, 0.f}, sn1 = sn0;
                if (rope) { const int t = (int)(R & 2047); const int pos = type ? (t & 63) : (t >> 6);
                    cs0 = *(const GAS f32x4*)(cosT + pos * 32 + i0); cs1 = *(const GAS f32x4*)(cosT + pos * 32 + i0 + 4); sn0 = *(const GAS f32x4*)(sinT + pos * 32 + i0); sn1 = *(const GAS f32x4*)(sinT + pos * 32 + i0 + 4); }
                const f32x4 a0 = acc[ai][0][m][0], a1 = acc[ai][0][m][1], b0 = acc[ai][1][m][0], b1 = acc[ai][1][m][1];
                const f32x4 o10 = a0 * cs0 - b0 * sn0, o11 = a1 * cs1 - b1 * sn1, o20 = a0 * sn0 + b0 * cs0, o21 = a1 * sn1 + b1 * cs1;
                if (!isq) { bf16_t* rowp = dst + R * 1024 + head * 128 + dbase; store8(rowp, o10, o11); store8(rowp + 32, o20, o21); }
                if (!isq) {
                    const float wkf = __builtin_amdgcn_exp2f(lf * (float)(255 - r)), wkb = __builtin_amdgcn_exp2f(lb * (float)r);
                    GAS unsigned short* kp = (GAS unsigned short*)(kft + ((size_t)u.pm * KTROWS + head * 128 + dbase) * 256 + r);
                    GAS unsigned short* kq = kp + (size_t)64 * KTROWS * 256;
#pragma unroll
                    for (int j = 0; j < 4; ++j) {
                        kp[(size_t)j * 256] = (unsigned short)cvtpk(o10[j] * wkf, 0.f); kp[(size_t)(4 + j) * 256] = (unsigned short)cvtpk(o11[j] * wkf, 0.f);
                        kp[(size_t)(32 + j) * 256] = (unsigned short)cvtpk(o20[j] * wkf, 0.f); kp[(size_t)(36 + j) * 256] = (unsigned short)cvtpk(o21[j] * wkf, 0.f);
                        kq[(size_t)j * 256] = (unsigned short)cvtpk(o10[j] * wkb, 0.f); kq[(size_t)(4 + j) * 256] = (unsigned short)cvtpk(o11[j] * wkb, 0.f);
                        kq[(size_t)(32 + j) * 256] = (unsigned short)cvtpk(o20[j] * wkb, 0.f); kq[(size_t)(36 + j) * 256] = (unsigned short)cvtpk(o21[j] * wkb, 0.f);
                    }
                }
                if (isq) {
                    const int slot = ((u.pm / nch) * 8 + head) * nch + (u.pm % nch);
                    const float wf = __builtin_amdgcn_exp2f(lf * (float)(r + 1)), wb = __builtin_amdgcn_exp2f(lb * (float)(256 - r));
                    bf16_t* ap = abuf + ((size_t)slot * 256 + r) * 512 + 256 + dbase;
                    store8(ap, o10 * wf, o11 * wf); store8(ap + 32, o20 * wf, o21 * wf); store8(ap + 128, o10 * wb, o11 * wb); store8(ap + 160, o20 * wb, o21 * wb);
                }
            }
        } else {
            size_t doff; int ld, c0, act;
            if (pn < 16) { doff = 0; ld = XLD; c0 = (pn - 8) * 256; act = 1; }
            else if (pn < 20) { doff = 0; ld = XLD; c0 = 2048 + (pn - 16) * 256; act = 0; }
            else if (pn < 28) {
                FOR_AI_M { const int r = 128 * ai + 64 * wr + 16 * m + fr; const size_t R = (size_t)u.pm * 256 + r;
                    store8(sg + R * XLD + 3072 + (pn - 20) * 128 + 32 * wc + 8 * fq, acc[ai][0][m][0] * acc[ai][1][m][0], acc[ai][0][m][1] * acc[ai][1][m][1]); }
                return;
            }
            else { doff = (size_t)MG * XLD; ld = 2048; c0 = (pn - 28) * 256; act = 2; }
            bf16_t* dst = sg + doff;
            FOR_AI_M {
                const int r = 128 * ai + 64 * wr + 16 * m + fr; const size_t R = (size_t)u.pm * 256 + r;
                FOR_BJ {
                    f32x4 v0 = acc[ai][bj][m][0], v1 = acc[ai][bj][m][1];
                    if (act == 1) { v0 = v0 * sig4(v0); v1 = v1 * sig4(v1); }
                    else if (act == 2) { v0 = sig4(v0); v1 = sig4(v1); }
                    store8(dst + R * ld + c0 + 128 * bj + 32 * wc + 8 * fq, v0, v1);
                }
            }
        }
    }
};

struct EpiKT {
    EPI_FLAGS(false, false, false, true)
    bf16_t *kft, *kbt; const float *cosT, *sinT, *cosT2, *sinT2, *l2g; int rope;
    __device__ __forceinline__ void operator()(Acc& acc, const Unit& u, int wr, int wc, int fr, int fq) const {
#pragma unroll
        for (int ai = 0; ai < 2; ++ai) {
            const int head = 2 * u.pm + ai; const float lf = l2g[head], lb = l2g[8 + head];
            FOR_BJ {
                const int c0 = 128 * bj + 32 * wc + 8 * fq;
                f32x4 wf0, wf1, wb0, wb1;
#pragma unroll
                for (int j = 0; j < 4; ++j) { wf0[j] = __builtin_amdgcn_exp2f(lf * (float)(255 - (c0 + j))); wf1[j] = __builtin_amdgcn_exp2f(lf * (float)(251 - (c0 + j))); wb0[j] = __builtin_amdgcn_exp2f(lb * (float)(c0 + j)); wb1[j] = __builtin_amdgcn_exp2f(lb * (float)(c0 + 4 + j)); }
#pragma unroll
                for (int mm = 0; mm < 2; ++mm) {
                    const int i = 16 * mm + fr;
                    f32x4 cs0 = {1.f, 1.f, 1.f, 1.f}, cs1 = cs0, sn0 = {0.f, 0.f, 0.f, 0.f}, sn1 = sn0;
                    if (rope) {
                        if (wr == 1) { const int pos0 = c0 & 63; cs0 = *(const GAS f32x4*)(cosT2 + i * 64 + pos0); cs1 = *(const GAS f32x4*)(cosT2 + i * 64 + pos0 + 4); sn0 = *(const GAS f32x4*)(sinT2 + i * 64 + pos0); sn1 = *(const GAS f32x4*)(sinT2 + i * 64 + pos0 + 4); }
                        else { const int pos = (((u.pn & 7) * 256 + c0) >> 6); const float c = cosT[pos * 32 + i], sv = sinT[pos * 32 + i]; cs0 = (f32x4){c, c, c, c}; cs1 = cs0; sn0 = (f32x4){sv, sv, sv, sv}; sn1 = sn0; }
                    }
                    const f32x4 a0 = acc[ai][bj][mm][0], a1 = acc[ai][bj][mm][1], b0 = acc[ai][bj][mm + 2][0], b1 = acc[ai][bj][mm + 2][1];
                    const f32x4 o10 = a0 * cs0 - b0 * sn0, o11 = a1 * cs1 - b1 * sn1, o20 = a0 * sn0 + b0 * cs0, o21 = a1 * sn1 + b1 * cs1;
                    const size_t row1 = (size_t)head * 128 + 64 * wr + 16 * mm + fr, row2 = row1 + 32;
                    const size_t tb = (size_t)u.pn * KTROWS;
                    store8(kft + (tb + row1) * 256 + c0, o10 * wf0, o11 * wf1); store8(kft + (tb + row2) * 256 + c0, o20 * wf0, o21 * wf1);
                    store8(kbt + (tb + row1) * 256 + c0, o10 * wb0, o11 * wb1); store8(kbt + (tb + row2) * 256 + c0, o20 * wb0, o21 * wb1);
                }
            }
        }
    }
};

struct EpiVT {
    EPI_FLAGS(false, false, false, true)
    bf16_t* bbuf; int nch;
    __device__ __forceinline__ void operator()(Acc& acc, const Unit& u, int wr, int wc, int fr, int fq) const {
        const int slot = ((u.pn / nch) * 8 + u.pm) * nch + (u.pn % nch);
        bf16_t* dst = bbuf + (size_t)slot * 256 * 512;
        FOR_AI_M { const int dv = 128 * ai + 64 * wr + 16 * m + fr;
            FOR_BJ store8(dst + (size_t)dv * 512 + 128 * bj + 32 * wc + 8 * fq, acc[ai][bj][m][0], acc[ai][bj][m][1]); }
    }
};

struct EpiKV {
    EPI_FLAGS(false, false, false, true)
    EpiKT kt; EpiVT vt;
    __device__ __forceinline__ void operator()(Acc& acc, const Unit& u, int wr, int wc, int fr, int fq) const {
        if (u.pm < 4) kt(acc, u, wr, wc, fr, fq);
        else { Unit v = u; v.pm = u.pm - 4; vt(acc, v, wr, wc, fr, fq); }
    }
};

struct EpiScores {
    EPI_FLAGS(false, false, false, true)
    bf16_t* abuf; const float* l2g;
    __device__ __forceinline__ void operator()(Acc& acc, const Unit& u, int wr, int wc, int fr, int fq) const {
        const float lf = l2g[u.pn], lb = l2g[8 + u.pn];
        bf16_t* dst = abuf + (size_t)u.pm * 256 * 512;
        FOR_AI_M { const int t = 128 * ai + 64 * wr + 16 * m + fr; const float rowe = -lf * (float)(t + 1);
            FOR_BJ { const int c0 = 128 * bj + 32 * wc + 8 * fq; f32x4 v0 = acc[ai][bj][m][0], v1 = acc[ai][bj][m][1];
#pragma unroll
                for (int j = 0; j < 4; ++j) {
                    const int d0 = t - (c0 + j), d1 = d0 - 4;
                    v0[j] *= __builtin_amdgcn_exp2f((d0 >= 0 ? lf : -lb) * (float)d0 + (d0 == 0 ? rowe + 1.0f : rowe));
                    v1[j] *= __builtin_amdgcn_exp2f((d1 >= 0 ? lf : -lb) * (float)d1 + (d1 == 0 ? rowe + 1.0f : rowe)); }
                store8(dst + (size_t)t * 512 + c0, v0, v1); } }
    }
};

struct EpiChain {
    EPI_FLAGS(false, true, true, true)
    bf16_t* bbuf;
    __device__ __forceinline__ void operator()(Acc& acc, const Unit& u, int wr, int wc, int fr, int fq) const {
        if (u.pm < 0) return;
        bf16_t* dst = bbuf + (size_t)u.pm * 256 * 512 + u.pn;
        FOR_AI_M { const int dv = 128 * ai + 64 * wr + 16 * m + fr;
            store8(dst + (size_t)dv * 512 + 32 * wc + 8 * fq, acc[ai][0][m][0], acc[ai][0][m][1]); }
    }
};

__device__ __forceinline__ void unpack8(const u32x4 w, f32x4& a, f32x4& b) {
    a[0] = __uint_as_float(w.x << 16); a[1] = __uint_as_float(w.x & 0xffff0000u); a[2] = __uint_as_float(w.y << 16); a[3] = __uint_as_float(w.y & 0xffff0000u);
    b[0] = __uint_as_float(w.z << 16); b[1] = __uint_as_float(w.z & 0xffff0000u); b[2] = __uint_as_float(w.w << 16); b[3] = __uint_as_float(w.w & 0xffff0000u); }
struct EpiO {
    EPI_FLAGS(false, false, false, true)
    bf16_t* xb; LAS unsigned char* xl; bf16_t* ob; int opitch;
    __device__ __forceinline__ void operator()(Acc& acc, const Unit& u, int wr, int wc, int fr, int fq) const {
        LAS f32x2* P = (LAS f32x2*)xl;
        bf16_t* obase = ob + ((size_t)u.f * 256 + 64 * wr + fr) * opitch + u.pn * 256 + 32 * wc + 8 * fq;
        bf16_t* base = xb + ((size_t)u.f * 256 + 64 * wr + fr) * XLD + u.pn * 256 + 32 * wc + 8 * fq;
        u32x4 gp[2][4][2];
        FOR_AI_M { FOR_BJ gp[ai][m][bj] = *(const GAS u32x4*)(base + (size_t)(128 * ai + 16 * m) * XLD + 128 * bj); }
        FOR_AI_M {
            float sm = 0.f;
            FOR_BJ { const f32x4 a = acc[ai][bj][m][0], b = acc[ai][bj][m][1]; sm += ((a[0] + a[1]) + (a[2] + a[3])) + ((b[0] + b[1]) + (b[2] + b[3])); }
            sm += __shfl_xor(sm, 16); sm += __shfl_xor(sm, 32);
            const float mw = sm * (1.0f / 64.0f); float qv = 0.f;
            FOR_BJ { const f32x4 a = acc[ai][bj][m][0] - mw, b = acc[ai][bj][m][1] - mw; qv += ((a[0] * a[0] + a[1] * a[1]) + (a[2] * a[2] + a[3] * a[3])) + ((b[0] * b[0] + b[1] * b[1]) + (b[2] * b[2] + b[3] * b[3])); }
            qv += __shfl_xor(qv, 16); qv += __shfl_xor(qv, 32);
            if (fq == 0) P[(128 * ai + 64 * wr + 16 * m + fr) * 4 + wc] = (f32x2){mw, qv};
        }
        asm volatile("s_waitcnt lgkmcnt(0)" ::: "memory"); __builtin_amdgcn_s_barrier(); asm volatile("" ::: "memory");
        FOR_AI_M {
            const int r = 128 * ai + 64 * wr + 16 * m + fr;
            const f32x2 p0 = P[r * 4 + 0], p1 = P[r * 4 + 1], p2 = P[r * 4 + 2], p3 = P[r * 4 + 3];
            const float mt = ((p0.x + p1.x) + (p2.x + p3.x)) * 0.25f;
            const float d0 = p0.x - mt, d1 = p1.x - mt, d2 = p2.x - mt, d3 = p3.x - mt;
            const float m2 = ((p0.y + p1.y) + (p2.y + p3.y)) + 64.0f * ((d0 * d0 + d1 * d1) + (d2 * d2 + d3 * d3));
            const float rs = rsqrtf(m2 * (1.0f / 256.0f) + EPS);
            FOR_BJ { f32x4 g0, g1; unpack8(gp[ai][m][bj], g0, g1);
                store8(obase + (size_t)(128 * ai + 16 * m) * opitch + 128 * bj, (acc[ai][bj][m][0] - mt) * rs * g0, (acc[ai][bj][m][1] - mt) * rs * g1); }
        }
        asm volatile("s_waitcnt lgkmcnt(0)" ::: "memory"); __builtin_amdgcn_s_barrier(); asm volatile("" ::: "memory");
    }
};

struct EpiMerge {
    static constexpr bool HAS_MID = true, CARRY = false, HALF_N = false, PERM = true; int mid_t;
    const bf16_t* gates; bf16_t* mrg;
    __device__ __forceinline__ void mid(Acc& acc, const Unit& u, int wr, int wc, int fr, int fq) const {
        FOR_AI_M { const size_t R = (size_t)u.pm * 256 + 128 * ai + 64 * wr + 16 * m + fr;
            FOR_BJ { const int col = u.pn * 256 + 128 * bj + 32 * wc + 8 * fq;
                f32x4 gr0, gr1, gc0, gc1; load8(gates + R * 2048 + col, gr0, gr1); load8(gates + R * 2048 + 1024 + col, gc0, gc1);
#pragma unroll
                for (int j = 0; j < 4; ++j) { acc[ai][bj][m][0][j] *= gr0[j] * __builtin_amdgcn_rcpf(gc0[j]); acc[ai][bj][m][1][j] *= gr1[j] * __builtin_amdgcn_rcpf(gc1[j]); } } }
    }
    __device__ __forceinline__ void operator()(Acc& acc, const Unit& u, int wr, int wc, int fr, int fq) const {
        FOR_AI_M { const size_t R = (size_t)u.pm * 256 + 128 * ai + 64 * wr + 16 * m + fr;
            FOR_BJ { const int col = u.pn * 256 + 128 * bj + 32 * wc + 8 * fq;
                f32x4 gc0, gc1; load8(gates + R * 2048 + 1024 + col, gc0, gc1);
                store8(mrg + R * 1024 + col, acc[ai][bj][m][0] * gc0, acc[ai][bj][m][1] * gc1); } }
    }
};

template <int MODE> struct EpiRes {
    EPI_FLAGS(false, false, false, true)
    const float* xin_f; const bf16_t* xin_b; float* xout_f; bf16_t* xout_b; const float* mod; int b0, ctx, which;
    __device__ __forceinline__ void operator()(Acc& acc, const Unit& u, int wr, int wc, int fr, int fq) const {
        const float* gv = mod + (size_t)(ctx ? 32 : (b0 + (u.pm >> 3))) * 6144 + which * 1024;
        FOR_BJ { const int col = u.pn * 256 + 128 * bj + 32 * wc + 8 * fq; const f32x4 g0 = *(const GAS f32x4*)(gv + col), g1 = *(const GAS f32x4*)(gv + col + 4);
            FOR_AI_M { const size_t R = (size_t)u.pm * 256 + 128 * ai + 64 * wr + 16 * m + fr;
                f32x4 x0, x1;
                if (MODE == 0) { x0 = *(const GAS f32x4*)(xin_f + R * 1024 + col); x1 = *(const GAS f32x4*)(xin_f + R * 1024 + col + 4); }
                else load8(xin_b + R * 1024 + col, x0, x1);
                const f32x4 v0 = x0 + g0 * acc[ai][bj][m][0], v1 = x1 + g1 * acc[ai][bj][m][1];
                if (MODE == 0) store8(xout_b + R * 1024 + col, v0, v1);
                else { *(GAS f32x4*)(xout_f + R * 1024 + col) = v0; *(GAS f32x4*)(xout_f + R * 1024 + col + 4) = v1; } } }
    }
};

struct EpiSwiglu {
    EPI_FLAGS(false, false, false, false)
    bf16_t* uo;
    __device__ __forceinline__ void operator()(Acc& acc, const Unit& u, int wr, int wc, int fr, int fq) const {
        FOR_AI_M { const size_t R = (size_t)u.pm * 256 + 128 * ai + 64 * wr + 16 * m + fr;
            const f32x4 g0 = acc[ai][0][m][0], g1 = acc[ai][0][m][1];
            store8(uo + R * DFF + u.pn * 128 + 32 * wc + 8 * fq, g0 * sig4(g0) * acc[ai][1][m][0], g1 * sig4(g1) * acc[ai][1][m][1]); }
    }
};

struct Sched2D {
    pg8::Order2D o; const char* A; const char* B; size_t sa, sb;
    __device__ bool next(int i, Unit& u) const { int pm, pn; if (!o.get(i, pm, pn)) return false; u.A = A + (size_t)pm * sa; u.B = B + (size_t)pn * sb; u.pm = pm; u.pn = pn; u.f = 1; u.sc = 0.f; return true; }
};
struct SchedSlots {
    int G, c, nslots, nch, mode; const char* A; const char* B;
    __device__ bool next(int i, Unit& u) const {
        const int slot = i * G + c; if (slot >= nslots) return false;
        const int bl = slot / (8 * nch), head = (slot / nch) & 7, ch = slot % nch, rowtile = bl * nch + ch;
        if (mode == 0) { u.A = A + (size_t)slot * SLOTB + 256 * 2; u.B = B + ((size_t)rowtile * 256 * 1024 + head * 128) * 2; }
        else { u.A = A + (size_t)slot * SLOTB; u.B = B + (size_t)slot * SLOTB; }
        u.pm = slot; u.pn = head; u.f = rowtile; u.sc = 0.f; return true;
    }
};
struct SchedChain {
    int G, c, b0; const char *cbb, *ckt, *bbuf, *kt; const float* l2g;
    __device__ bool next(int i, Unit& u) const {
        const int ch = c + (i >> 3) * G, step = i & 7; if (ch >= 128) return false;
        const int bl = ch >> 4, head = (ch >> 1) & 7, dir = ch & 1;
        const size_t dirb = (size_t)dir * 64 * KTROWS * 256 * 2, hb_ = (size_t)head * 128 * 256 * 2;
        if (step == 0) {
            u.A = cbb + (size_t)((b0 + bl) * 8 + head) * SLOTB; u.B = ckt + dirb + (size_t)(b0 + bl) * KTROWS * 256 * 2 + hb_;
            u.pm = (bl * 8 + head) * 8 + (dir ? 7 : 0);
        } else {
            const int cc = dir ? 8 - step : step - 1;
            u.A = bbuf + (size_t)((bl * 8 + head) * 8 + cc) * SLOTB; u.B = kt + dirb + (size_t)(bl * 8 + cc) * KTROWS * 256 * 2 + hb_;
            u.pm = (bl * 8 + head) * 8 + (dir ? cc - 1 : cc + 1);
        }
        u.pn = dir ? 384 : 256; u.f = (step == 0); u.sc = exp2f(256.0f * l2g[dir * 8 + head]);
        return true;
    }
};

struct Args { const float* in[17]; float* out; unsigned char* ws; };
enum { I_X = 0, I_C, I_CTX, I_CCTX, I_NMW, I_ADAW, I_ADAB, I_WIN, I_DECAY, I_CONVW, I_WRO, I_WCO, I_WO, I_NFW, I_WFI, I_WFO, I_FNW };

template <bool XBF> __device__ __forceinline__ void norm_mod_phase(const void* xv, int nrows, const float* nw, const float* mod, int b0, int ctx, int sidx, bf16_t* dst) {
    int lane_ = threadIdx.x & 63; asm volatile("" : "+v"(lane_)); const int lane = lane_, gw = blockIdx.x * 8 + __builtin_amdgcn_readfirstlane(threadIdx.x >> 6), stride = gridDim.x * 8;
    for (int pr = gw; pr < nrows / 2; pr += stride) {
        const int row = 2 * pr;
        const float* sh = mod + (size_t)(ctx ? 32 : b0 + (row >> 11)) * 6144 + sidx * 1024; const float* sc = sh + 1024;
        f32x4 v[4], u[4]; float ss = 0.f, st = 0.f;
        if (XBF) { const bf16_t* xr = (const bf16_t*)xv + (size_t)row * 1024;
#pragma unroll
            for (int q = 0; q < 4; ++q) { v[q] = load4(xr + q * 256 + lane * 4); u[q] = load4(xr + 1024 + q * 256 + lane * 4); } }
        else { const float* xr = (const float*)xv + (size_t)row * 1024;
#pragma unroll
            for (int q = 0; q < 4; ++q) { v[q] = *(const GAS f32x4*)(xr + q * 256 + lane * 4); u[q] = *(const GAS f32x4*)(xr + 1024 + q * 256 + lane * 4); } }
#pragma unroll
        for (int q = 0; q < 4; ++q) { ss += v[q][0] * v[q][0] + v[q][1] * v[q][1] + v[q][2] * v[q][2] + v[q][3] * v[q][3]; st += u[q][0] * u[q][0] + u[q][1] * u[q][1] + u[q][2] * u[q][2] + u[q][3] * u[q][3]; }
#pragma unroll
        for (int o = 32; o > 0; o >>= 1) { ss += __shfl_xor(ss, o); st += __shfl_xor(st, o); }
        const float rs = rsqrtf(ss * (1.0f / 1024.0f) + EPS), rt = rsqrtf(st * (1.0f / 1024.0f) + EPS);
#pragma unroll
        for (int q = 0; q < 4; ++q) { const int c = q * 256 + lane * 4;
            const f32x4 w4 = *(const GAS f32x4*)(nw + c), s4 = *(const GAS f32x4*)(sc + c) + 1.0f, h4 = *(const GAS f32x4*)(sh + c);
            store4(dst + (size_t)row * 1024 + c, (v[q] * rs * w4) * s4 + h4);
            store4(dst + (size_t)(row + 1) * 1024 + c, (u[q] * rt * w4) * s4 + h4); }
    }
}
__device__ __forceinline__ void conv_phase(bf16_t* xbuf, const float* convw, int nrows, int seqmask, int wg0, int nwg, bf16_t* dbase, int dpitch) {
    int lane_ = threadIdx.x & 63; asm volatile("" : "+v"(lane_)); const int lane = lane_, gw = ((int)blockIdx.x - wg0) * 8 + __builtin_amdgcn_readfirstlane(threadIdx.x >> 6), stride = nwg * 8;
    for (int pr = gw; pr < nrows / 2; pr += stride) {
        const int row = 2 * pr, t = row & seqmask;
        const bf16_t* cr = xbuf + (size_t)row * XLD + 2048 + lane * 8;
        u32x4 cbA[2], cbB[2], wP[2], wA[2], wB[2], wN[2];
        const bool hp = t > 0, hn = t + 1 < seqmask;
#pragma unroll
        for (int q = 0; q < 2; ++q) {
            cbA[q] = *(const GAS u32x4*)(cr + q * 512); cbB[q] = *(const GAS u32x4*)(cr + XLD + q * 512);
            wA[q] = *(const GAS u32x4*)(cr + 1024 + q * 512); wB[q] = *(const GAS u32x4*)(cr + XLD + 1024 + q * 512);
            wP[q] = (u32x4){0u, 0u, 0u, 0u}; wN[q] = wP[q];
            if (hp) wP[q] = *(const GAS u32x4*)(cr - XLD + 1024 + q * 512);
            if (hn) wN[q] = *(const GAS u32x4*)(cr + 2 * XLD + 1024 + q * 512);
        }
#pragma unroll
        for (int q = 0; q < 2; ++q) { const float* wp = convw + q * 512 + lane * 8;
            const f32x4 w00 = *(const GAS f32x4*)(wp), w01 = *(const GAS f32x4*)(wp + 4), w10 = *(const GAS f32x4*)(wp + 1024), w11 = *(const GAS f32x4*)(wp + 1028), w20 = *(const GAS f32x4*)(wp + 2048), w21 = *(const GAS f32x4*)(wp + 2052);
            f32x4 p0, p1, x0, x1, y0, y1, n0, n1, c0, c1, d0, d1;
            unpack8(wP[q], p0, p1); unpack8(wA[q], x0, x1); unpack8(wB[q], y0, y1); unpack8(wN[q], n0, n1);
            unpack8(cbA[q], c0, c1); unpack8(cbB[q], d0, d1);
            bf16_t* dr = dbase + (size_t)row * dpitch + lane * 8;
            store8(dr + q * 512, c0 * (p0 * w00 + x0 * w10 + y0 * w20), c1 * (p1 * w01 + x1 * w11 + y1 * w21));
            store8(dr + dpitch + q * 512, d0 * (x0 * w00 + y0 * w10 + n0 * w20), d1 * (x1 * w01 + y1 * w11 + n1 * w21)); }
    }
}
__device__ __forceinline__ void final_norm_phase(float* x, int nrows, const float* nw) {
    int lane_ = threadIdx.x & 63; asm volatile("" : "+v"(lane_)); const int lane = lane_, gw = blockIdx.x * 8 + __builtin_amdgcn_readfirstlane(threadIdx.x >> 6), stride = gridDim.x * 8;
    for (int qr = gw; qr < nrows / 4; qr += stride) {
        float* xr = x + (size_t)qr * 4096; f32x4 v[4][4]; float ss[4];
#pragma unroll
        for (int r = 0; r < 4; ++r)
#pragma unroll
            for (int q = 0; q < 4; ++q) v[r][q] = *(const GAS f32x4*)(xr + r * 1024 + q * 256 + lane * 4);
#pragma unroll
        for (int r = 0; r < 4; ++r) { ss[r] = 0.f;
#pragma unroll
            for (int q = 0; q < 4; ++q) ss[r] += v[r][q][0] * v[r][q][0] + v[r][q][1] * v[r][q][1] + v[r][q][2] * v[r][q][2] + v[r][q][3] * v[r][q][3]; }
#pragma unroll
        for (int o = 32; o > 0; o >>= 1) {
#pragma unroll
            for (int r = 0; r < 4; ++r) ss[r] += __shfl_xor(ss[r], o); }
#pragma unroll
        for (int q = 0; q < 4; ++q) { const int c = q * 256 + lane * 4; const f32x4 w4 = *(const GAS f32x4*)(nw + c);
#pragma unroll
            for (int r = 0; r < 4; ++r) *(GAS f32x4*)(xr + r * 1024 + c) = v[r][q] * rsqrtf(ss[r] * (1.0f / 1024.0f) + EPS) * w4; }
    }
}

__device__ __forceinline__ int lane_col(int e) { return 32 * (e >> 5) + 16 * ((e >> 2) & 1) + 4 * ((e >> 3) & 3) + (e & 3); }
__device__ __forceinline__ int rope_perm(int n) { const int head = n >> 7, d = n & 127, x2 = (d >> 5) & 1, e = 64 * (head & 1) + (d < 64 ? 0 : 32) + (d & 31); return (head >> 1) * 256 + 128 * x2 + lane_col(e); }
__device__ __forceinline__ int nat8_perm(int c) { return (c & ~127) + lane_col(c & 127); }
__device__ __forceinline__ int ccu_perm(int n) { const int cu = n >> 10, ch = n & 1023; return (ch >> 7) * 256 + 128 * cu + lane_col(ch & 127); }
__device__ __forceinline__ int swiglu_perm(int c) { const int up = c >= DFF, f = c - DFF * up, tile = f >> 7, u = f & 127; return tile * 256 + 128 * up + lane_col(u); }
struct ConvJob { const float* src; int ldsrc, K, c0, ncol; bf16_t* dst; int lddst, dcol0, row0, perm; float scale; };
__device__ __forceinline__ void convert_job(const ConvJob& J, float* tl  ) {
    const int tid = threadIdx.x, nkt = J.K / 128, nnt = J.ncol / 128, ntile = nkt * nnt;
    for (int tile = blockIdx.x; tile < ntile; tile += gridDim.x) {
        const int k0 = (tile % nkt) * 128, n0 = (tile / nkt) * 128;
        { const int tx = tid & 127, ty = tid >> 7;
          float v[32];
#pragma unroll
          for (int p = 0; p < 32; ++p) v[p] = J.src[(size_t)(k0 + ty + 4 * p) * J.ldsrc + J.c0 + n0 + tx];
#pragma unroll
          for (int p = 0; p < 32; ++p) tl[(ty + 4 * p) * 129 + tx] = v[p]; }
        __syncthreads();
#pragma unroll
        for (int h = 0; h < 4; ++h) {
          const int n = (tid >> 4) + 32 * h, kq = tid & 15; const int nl = n0 + n;
          const int prow = J.perm == 1 ? rope_perm(nl) : (J.perm == 2 ? swiglu_perm(nl) : (J.perm == 3 ? nat8_perm(nl) : (J.perm == 5 ? ccu_perm(nl) : nl)));
          u32x4 w; float v[8];
#pragma unroll
          for (int jj = 0; jj < 8; ++jj) v[jj] = tl[(kq * 8 + jj) * 129 + n] * J.scale;
          w.x = cvtpk(v[0], v[1]); w.y = cvtpk(v[2], v[3]); w.z = cvtpk(v[4], v[5]); w.w = cvtpk(v[6], v[7]);
          *(GAS u32x4*)(J.dst + (size_t)(J.row0 + prow) * J.lddst + J.dcol0 + k0 + kq * 8) = w; }
        __syncthreads();
    }
}

__device__ __forceinline__ void e1_phase(const Args& a, unsigned char* ws0, int l, int g) {
    unsigned char* ws = lw(ws0);
    const int ctx = g < 0;
    const float* xin = ctx ? (l == 0 ? a.in[I_CTX] : (const float*)(ws + WS_XC)) : ((l == 0 ? a.in[I_X] : (const float*)a.out) + (size_t)g * MG * 1024);
    norm_mod_phase<false>(xin, ctx ? MC : MG, a.in[I_NMW] + l * 1024, (const float*)(ws + WS_MOD) + (size_t)l * 33 * 6144, ctx ? 0 : g * GB, ctx, 0, (bf16_t*)(ws + WS_H));
}
#ifndef PHM
#define PHM 0xFFFF
#endif
#ifndef DUPM
#define DUPM 0
#endif
#define REP(bit) for (int rep_ = 0; rep_ <= ((DUPM >> (bit)) & 1); ++rep_)
__global__ void __launch_bounds__(512, 2) mega_fwd(Args a) {
    extern __shared__ __attribute__((aligned(16))) unsigned char lds_raw[];
    LAS unsigned char* lds = (LAS unsigned char*)lds_raw;
    cg::grid_group grid = cg::this_grid();
    unsigned char* ws = a.ws;
    const int G = gridDim.x, cid = blockIdx.x, tid = threadIdx.x;
    float* sc = (float*)(ws + WS_SC); float* l2g_all = (float*)(ws + WS_L2G);
    float* cosT_ = (float*)(ws + WS_ROPE); float* sinT_ = cosT_ + 2048; float* cosT2_ = cosT_ + 4096; float* sinT2_ = cosT_ + 6144;
    float* mod_all = (float*)(ws + WS_MOD);

    {
        const int gt = cid * 512 + tid, gs = G * 512;
        if (cid == 0) { unsigned* bw = (unsigned*)(ws + WS_BAR); for (int i = tid; i < XCD_BAR_WORDS; i += 512) bw[i] = 0u; }
        if (cid == 1) { float* zv = (float*)(ws + WS_ZERO); for (int i = tid; i < 1024; i += 512) zv[i] = 0.f; }
        for (int i = gt; i < 33 * 1024; i += gs) { const float v = (i < 32 * 1024) ? a.in[I_C][i] : a.in[I_CCTX][i - 32 * 1024]; sc[i] = v / (1.0f + expf(-v)); }
        if (gt < 32) { const float xl = a.in[I_DECAY][gt]; l2g_all[gt] = -log1pf(expf(-xl)) * 1.4426950408889634f; }
        for (int i = gt; i < 2048; i += gs) { const int pos = i >> 5, fi = i & 31; const float fr_ = exp2f(-(float)fi * (13.287712379549449f / 32.0f)); const float ang = (float)pos * fr_;
            const float c = cosf(ang), s = sinf(ang); cosT_[pos * 32 + fi] = c; sinT_[pos * 32 + fi] = s; cosT2_[fi * 64 + pos] = c; sinT2_[fi * 64 + pos] = s; }
        float* tl = (float*)lds_raw;
        REP(8) for (int l = 0; l < 2; ++l) {
            bf16_t* wnat = (bf16_t*)(ws + WS_WNAT) + (size_t)l * NNAT * 1024;
            const float* win = a.in[I_WIN] + (size_t)l * 1024 * 11264;
            const float ks = 0.08838834764831845f;
            const ConvJob jobs[13] = {
                {win, 11264, 1024, 0, 1024, wnat, 1024, 0, 0, 1, 1.0f},
                {win, 11264, 1024, 1024, 1024, wnat, 1024, 0, 1024, 1, ks},
                {win, 11264, 1024, 1024, 1024, (bf16_t*)(ws + WS_WKN) + (size_t)l * 3072 * 1024, 1024, 0, 0, 0, ks},
                {win, 11264, 1024, 2048, 2048, (bf16_t*)(ws + WS_WKN) + (size_t)l * 3072 * 1024, 1024, 0, 1024, 0, 1.0f},
                {win, 11264, 1024, 4096, 2048, wnat, 1024, 0, 2048, 3, 1.0f},
                {win, 11264, 1024, 6144, 1024, wnat, 1024, 0, 4096, 3, 1.0f},
                {win, 11264, 1024, 7168, 2048, wnat, 1024, 0, 5120, 5, 1.0f},
                {win, 11264, 1024, 9216, 2048, wnat, 1024, 0, 7168, 3, 1.0f},
                {a.in[I_WRO] + (size_t)l * 2048 * 1024, 1024, 2048, 0, 1024, (bf16_t*)(ws + WS_WY) + (size_t)l * 1024 * 3072, 3072, 0, 0, 0, 1.0f},
                {a.in[I_WCO] + (size_t)l * 1024 * 1024, 1024, 1024, 0, 1024, (bf16_t*)(ws + WS_WY) + (size_t)l * 1024 * 3072, 3072, 2048, 0, 0, 1.0f},
                {a.in[I_WO] + (size_t)l * 1024 * 1024, 1024, 1024, 0, 1024, (bf16_t*)(ws + WS_WO) + (size_t)l * 1024 * 1024, 1024, 0, 0, 0, 1.0f},
                {a.in[I_WFI] + (size_t)l * 1024 * 5632, 5632, 1024, 0, 5632, (bf16_t*)(ws + WS_WFI) + (size_t)l * 5632 * 1024, 1024, 0, 0, 2, 1.0f},
                {a.in[I_WFO] + (size_t)l * DFF * 1024, 1024, DFF, 0, 1024, (bf16_t*)(ws + WS_WFO) + (size_t)l * 1024 * DFF, DFF, 0, 0, 0, 1.0f},
            };
#pragma unroll
            for (int j = 0; j < 13; ++j) convert_job(jobs[j], tl);
        }
    }
    grid.sync();
    volatile LAS unsigned* xst = (volatile LAS unsigned*)(lds + 131072);
    if (tid == 0) { xst[0] = 0u; xst[1] = 0u; }
    __syncthreads();
    const XcdBarrier xb = xcd_barrier_post((unsigned*)(ws + WS_BAR), xst);

    {
        float* red = (float*)lds_raw;
        for (int blk = cid; blk < 192; blk += G) {
            const int l = blk / 96, n0 = (blk % 96) * 64, ksl = tid >> 6, col = tid & 63;
            const float* w = a.in[I_ADAW] + (size_t)l * 1024 * 6144 + n0 + col;
            float accv[33];
#pragma unroll
            for (int b = 0; b < 33; ++b) accv[b] = 0.f;
#pragma unroll 1
            for (int k = ksl * 128; k < ksl * 128 + 128; k += 8) {
                float wv[8];
#pragma unroll
                for (int i = 0; i < 8; ++i) wv[i] = w[(size_t)(k + i) * 6144];
#pragma unroll
                for (int b = 0; b < 33; ++b) { const f32x4 s0 = *(const GAS f32x4*)(sc + b * 1024 + k), s1 = *(const GAS f32x4*)(sc + b * 1024 + k + 4);
                    accv[b] += ((s0[0] * wv[0] + s0[1] * wv[1]) + (s0[2] * wv[2] + s0[3] * wv[3])) + ((s1[0] * wv[4] + s1[1] * wv[5]) + (s1[2] * wv[6] + s1[3] * wv[7])); } }
#pragma unroll
            for (int b = 0; b < 33; ++b) red[(ksl * 33 + b) * 64 + col] = accv[b];
            __syncthreads();
            for (int i = tid; i < 33 * 64; i += 512) { float s = a.in[I_ADAB][l * 6144 + n0 + (i & 63)];
#pragma unroll
                for (int k8 = 0; k8 < 8; ++k8) s += red[k8 * 33 * 64 + i];
                mod_all[((size_t)l * 33 + (i >> 6)) * 6144 + n0 + (i & 63)] = s; }
            __syncthreads();
        }
    }
    { xcd_barrier(xb); if (DUPM & (1 << 11)) xcd_barrier(xb); }

#define P_hb ((bf16_t*)(lw(ws) + WS_H))
#define P_qb ((bf16_t*)(lw(ws) + WS_Q))
#define P_kb ((bf16_t*)(lw(ws) + WS_K))
#define P_ktb ((bf16_t*)(lw(ws) + WS_KT))
#define P_cktb ((bf16_t*)(lw(ws) + WS_CKT))
#define P_sgb ((bf16_t*)(lw(ws) + WS_SG))
#define P_convb ((bf16_t*)(lw(ws) + WS_CONV))
#define P_gatesb ((bf16_t*)(lw(ws) + WS_GATES))
#define P_abuf ((bf16_t*)(lw(ws) + WS_ABUF))
#define P_bbuf ((bf16_t*)(lw(ws) + WS_BBUF))
#define P_cbb ((bf16_t*)(lw(ws) + WS_CBB))
#define P_ob ((bf16_t*)(lw(ws) + WS_O))
#define P_yb ((bf16_t*)(lw(ws) + WS_Y))
#define P_mrgb ((bf16_t*)(lw(ws) + WS_MRG))
#define P_h2b ((bf16_t*)(lw(ws) + WS_H2))
#define P_ub ((bf16_t*)(lw(ws) + WS_U))
#define P_xc ((float*)(lw(ws) + WS_XC))
#define P_cosT ((const float*)(lw(ws) + WS_ROPE))
#define P_sinT ((const float*)(lw(ws) + WS_ROPE + 8192))
#define P_cosT2 ((const float*)(lw(ws) + WS_ROPE + 16384))
#define P_sinT2 ((const float*)(lw(ws) + WS_ROPE + 24576))
#define P_mod ((const float*)(lw(ws) + WS_MOD) + (size_t)l * 33 * 6144)
#define P_l2g ((const float*)(lw(ws) + WS_L2G) + l * 16)
#define P_wnat ((const bf16_t*)(lw(ws) + WS_WNAT) + (size_t)l * NNAT * 1024)
#define P_wkn ((const bf16_t*)(lw(ws) + WS_WKN) + (size_t)l * 3072 * 1024)
#define P_wy ((const bf16_t*)(lw(ws) + WS_WY) + (size_t)l * 1024 * 3072)
#define P_wo ((const bf16_t*)(lw(ws) + WS_WO) + (size_t)l * 1024 * 1024)
#define P_wfi ((const bf16_t*)(lw(ws) + WS_WFI) + (size_t)l * 5632 * 1024)
#define P_wfo ((const bf16_t*)(lw(ws) + WS_WFO) + (size_t)l * 1024 * DFF)
#define AIN(i) ((const float*)lw((unsigned char*)a.in[i]))
#define P_nmw (AIN(I_NMW) + l * 1024)
#define P_nfw (AIN(I_NFW) + l * 1024)
#define P_convw (AIN(I_CONVW) + (size_t)l * 3 * 1024)
#define AOUT ((float*)lw((unsigned char*)a.out))

    bool e1_pending = true;
    for (int l = 0; l < 2; ++l) {
        for (int g = -1; g < NGROUP; ++g) {
            const int ctx = g < 0;
            const int nrows = ctx ? MC : MG, nrt = nrows / 256, nch = ctx ? 1 : 8, b0 = ctx ? 0 : g * GB;
            const bool full = !(ctx && l == 1);
            #define P_xin0 (ctx ? (l == 0 ? AIN(I_CTX) : P_xc) : ((l == 0 ? AIN(I_X) : AOUT) + (size_t)g * MG * 1024))
#define P_xres (ctx ? P_xc : AOUT + (size_t)g * MG * 1024)

            if (e1_pending) { e1_phase(a, ws, l, g); { xcd_barrier(xb); if (DUPM & (1 << 11)) xcd_barrier(xb); } }
            e1_pending = true;
            REP(1) {
            if (full) {
                Sched2D S; S.o.init(nrt, NNAT / 256, G, cid); S.A = (const char*)P_hb; S.B = (const char*)P_wnat; S.sa = S.sb = (size_t)256 * 1024 * 2;
                EpiNat E; E.mid_t = -1; E.q = P_qb; E.sg = P_sgb; E.abuf = P_abuf; E.kft = ctx ? P_cktb : P_ktb; E.cosT = P_cosT; E.sinT = P_sinT; E.l2g = P_l2g; E.nch = nch; E.rope = !ctx;
                if (PHM & (1 << 0)) pg8::gemm_phase(lds, 1024, 1024, 1024, S, E);
            }
            {
                if (full) {
                    Sched2D S; S.o.init(8, nrt, G, cid); S.A = (const char*)(P_wkn + (size_t)1024 * 1024); S.B = (const char*)P_hb; S.sa = S.sb = (size_t)256 * 1024 * 2;
                    EpiVT E; E.mid_t = -1; E.bbuf = ctx ? P_cbb : P_bbuf; E.nch = nch;
                    if (PHM & (1 << 1)) pg8::gemm_phase(lds, 1024, 1024, 1024, S, E);
                } else {
                Sched2D S; S.o.init(12, nrt, G, cid); S.A = (const char*)P_wkn; S.B = (const char*)P_hb; S.sa = S.sb = (size_t)256 * 1024 * 2;
                EpiKV E; E.mid_t = -1; E.kt.kft = ctx ? P_cktb : P_ktb; E.kt.kbt = E.kt.kft + (size_t)64 * KTROWS * 256; E.kt.cosT = P_cosT; E.kt.sinT = P_sinT; E.kt.cosT2 = P_cosT2; E.kt.sinT2 = P_sinT2; E.kt.l2g = P_l2g; E.kt.rope = !ctx;
                E.vt.bbuf = ctx ? P_cbb : P_bbuf; E.vt.nch = nch;
                if (PHM & (1 << 1)) pg8::gemm_phase(lds, 1024, 1024, 1024, S, E);
                }
            }
            { xcd_barrier(xb); if (DUPM & (1 << 11)) xcd_barrier(xb); } }
            if (!full) continue;
            REP(2) {
                const int half = ctx ? 0 : G / 2;
                if (cid >= half) {
                    SchedSlots S; S.G = G - half; S.c = cid - half; S.nslots = nrt * 8; S.nch = nch; S.mode = 0; S.A = (const char*)P_abuf; S.B = (const char*)P_kb;
                    EpiScores E; E.mid_t = -1; E.abuf = P_abuf; E.l2g = P_l2g;
                    int k128 = 128; asm volatile("" : "+s"(k128));
                    if (PHM & (1 << 3)) pg8::gemm_phase(lds, 512, 1024, k128, S, E);
                    if (rep_ == 0) conv_phase(P_sgb, P_convw, nrows, ctx ? 255 : 2047, half, G - half, P_sgb + 2048, XLD);
                    else if (DUPM & (1 << 12)) conv_phase(P_sgb, P_convw, nrows, ctx ? 255 : 2047, half, G - half, P_hb, 1024);
                } else {
                    SchedChain S; S.G = half; S.c = cid; S.b0 = b0; S.cbb = (const char*)P_cbb; S.ckt = (const char*)P_cktb; S.bbuf = (const char*)P_bbuf; S.kt = (const char*)P_ktb; S.l2g = P_l2g;
                    EpiChain E; E.mid_t = -1; E.bbuf = P_bbuf;
                    if (PHM & (1 << 4)) pg8::gemm_phase(lds, 512, 256, 256, S, E);
                }
            { xcd_barrier(xb); if (DUPM & (1 << 11)) xcd_barrier(xb); } }
            REP(3) {
                SchedSlots S; S.G = G; S.c = cid; S.nslots = nrt * 8; S.nch = nch; S.mode = 1; S.A = (const char*)P_abuf; S.B = (const char*)(ctx ? P_cbb : P_bbuf);
                EpiO E; E.mid_t = -1; E.xb = P_sgb; E.xl = lds + 131072 + 256; E.ob = rep_ == 0 ? P_sgb : P_hb; E.opitch = rep_ == 0 ? XLD : 2048;
                if (PHM & (1 << 5)) pg8::gemm_phase(lds, 512, 512, ctx ? 256 : 512, S, E);
            { xcd_barrier(xb); if (DUPM & (1 << 11)) xcd_barrier(xb); } }
            REP(5) {
                Sched2D S; S.o.init(nrt, 4, G, cid); S.A = (const char*)P_sgb; S.B = (const char*)P_wy; S.sa = (size_t)256 * XLD * 2; S.sb = (size_t)256 * 3072 * 2;
                EpiMerge E; E.mid_t = 32; E.gates = P_gatesb; E.mrg = P_mrgb;
                if (PHM & (1 << 6)) pg8::gemm_phase(lds, XLD, 3072, 3072, S, E);
            { xcd_barrier(xb); if (DUPM & (1 << 11)) xcd_barrier(xb); } }
            {
                Sched2D S; S.o.init(nrt, 4, G, cid); S.A = (const char*)P_mrgb; S.B = (const char*)P_wo; S.sa = S.sb = (size_t)256 * 1024 * 2;
                EpiRes<0> E; E.mid_t = -1; E.xin_f = P_xin0; E.xin_b = nullptr; E.xout_f = nullptr; E.xout_b = P_qb; E.mod = P_mod; E.b0 = b0; E.ctx = ctx; E.which = 2;
                if (PHM & (1 << 7)) pg8::gemm_phase(lds, 1024, 1024, 1024, S, E);
            }
            { xcd_barrier(xb); if (DUPM & (1 << 11)) xcd_barrier(xb); }
            REP(6) { norm_mod_phase<true>(P_qb, nrows, P_nfw, P_mod, b0, ctx, 3, P_h2b);
            { xcd_barrier(xb); if (DUPM & (1 << 11)) xcd_barrier(xb); } }
            REP(7) {
                Sched2D S; S.o.init(nrt, 22, G, cid); S.A = (const char*)P_h2b; S.B = (const char*)P_wfi; S.sa = S.sb = (size_t)256 * 1024 * 2;
                EpiSwiglu E; E.mid_t = -1; E.uo = P_ub;
                if (PHM & (1 << 8)) pg8::gemm_phase(lds, 1024, 1024, 1024, S, E);
            { xcd_barrier(xb); if (DUPM & (1 << 11)) xcd_barrier(xb); } }
            {
                Sched2D S; S.o.init(nrt, 4, G, cid); S.A = (const char*)P_ub; S.B = (const char*)P_wfo; S.sa = S.sb = (size_t)256 * DFF * 2;
                EpiRes<1> E; E.mid_t = -1; E.xin_f = nullptr; E.xin_b = P_qb; E.xout_f = P_xres; E.xout_b = nullptr; E.mod = P_mod; E.b0 = b0; E.ctx = ctx; E.which = 5;
                if (PHM & (1 << 9)) pg8::gemm_phase(lds, DFF, DFF, DFF, S, E);
            }
            { int g2 = g + 1, l2 = l; if (g2 == NGROUP) { g2 = -1; l2 = l + 1; }
              if (l2 < 2) { e1_phase(a, ws, l2, g2); e1_pending = false; } }
            { xcd_barrier(xb); if (DUPM & (1 << 11)) xcd_barrier(xb); }
        }
    }
    final_norm_phase(AOUT, NB * T, AIN(I_FNW));
}

extern "C" void kernel_launch(void* const* d_in, const int* in_sizes, int n_in, void* d_out, int out_size, void* d_ws, size_t ws_size, hipStream_t stream) {
    static int grid = 0;
    if (grid == 0) {
        if (n_in != 17 || ws_size < WS_END) { fprintf(stderr, "kernel_launch: need 17 inputs and %zu bytes of workspace (got %d, %zu)\n", (size_t)WS_END, n_in, ws_size); grid = -1; return; }
        int dev = 0, cus = 0, per_cu = 0;
        hipGetDevice(&dev);
        hipDeviceGetAttribute(&cus, hipDeviceAttributeMultiprocessorCount, dev);
        if (hipFuncSetAttribute((const void*)mega_fwd, hipFuncAttributeMaxDynamicSharedMemorySize, LDS_BYTES) != hipSuccess) { fprintf(stderr, "kernel_launch: hipFuncSetAttribute failed\n"); grid = -1; return; }
        if (hipOccupancyMaxActiveBlocksPerMultiprocessor(&per_cu, (const void*)mega_fwd, 512, LDS_BYTES) != hipSuccess || per_cu < 1) { fprintf(stderr, "kernel_launch: occupancy query says %d\n", per_cu); per_cu = 1; }
        (void)hipGetLastError();
        grid = cus;
    }
    if (grid < 0) return;
    Args a{};
    for (int i = 0; i < 17; ++i) a.in[i] = (const float*)d_in[i];
    a.out = (float*)d_out; a.ws = (unsigned char*)d_ws;
    void* args[] = {&a};
    hipError_t e = hipLaunchCooperativeKernel((const void*)mega_fwd, dim3(grid), dim3(512), args, LDS_BYTES, stream);
    if (e != hipSuccess) fprintf(stderr, "cooperative launch failed: %s (grid %d)\n", hipGetErrorString(e), grid);
}
```

```cpp
#include <hip/hip_runtime.h>
#include <hip/hip_cooperative_groups.h>
#include <cstdio>
#include <cstdint>
namespace cg = cooperative_groups;

#define LAS __attribute__((address_space(3)))
#define GAS __attribute__((address_space(1)))
typedef unsigned short bf16_t;
typedef short bf16x8 __attribute__((ext_vector_type(8)));
typedef float f32x4 __attribute__((ext_vector_type(4)));
typedef float f32x2 __attribute__((ext_vector_type(2)));
typedef unsigned u32x2 __attribute__((ext_vector_type(2)));
typedef unsigned u32x4 __attribute__((ext_vector_type(4)));
typedef __bf16 bf16x2_t __attribute__((ext_vector_type(2)));

constexpr int D = 1024, NB = 32, T = 2048, TC = 256, NH = 8, DFF = 2816;
constexpr int GB = 8, MG = GB * T, NGROUP = NB / GB, MC = NB * TC;
constexpr int NNAT = 9216;
constexpr int KTLD = 16384, KTROWS = 1152;
constexpr float EPS = 1e-6f;

constexpr size_t WS_SC = 0;
constexpr size_t WS_L2G = WS_SC + 33 * 1024 * 4;
constexpr size_t WS_BAR = WS_L2G + 4096;
constexpr size_t WS_ZERO = WS_BAR + 16384;
constexpr size_t WS_ROPE = WS_ZERO + 4096;
constexpr size_t WS_MOD = WS_ROPE + 4 * 8192;
constexpr size_t WS_WNAT = (WS_MOD + 2 * 33 * 6144 * 4 + 4095) & ~size_t(4095);
constexpr size_t WS_WKN = WS_WNAT + (size_t)2 * NNAT * 1024 * 2;
constexpr size_t WS_WY = WS_WKN + (size_t)2 * 3072 * 1024 * 2;
constexpr size_t WS_WO = WS_WY + (size_t)2 * 1024 * 3072 * 2;
constexpr size_t WS_WFI = WS_WO + (size_t)2 * 1024 * 1024 * 2;
constexpr size_t WS_WFO = WS_WFI + (size_t)2 * 5632 * 1024 * 2;
constexpr size_t WS_XC = WS_WFO + (size_t)2 * 1024 * 2816 * 2;
constexpr size_t WS_CKT = WS_XC + (size_t)MC * 1024 * 4;
constexpr size_t WS_CBB = WS_CKT + (size_t)2 * KTROWS * KTLD * 2;
constexpr size_t WS_H = WS_CBB + (size_t)256 * 256 * 512 * 2;
constexpr size_t WS_Q = WS_H + (size_t)MG * 1024 * 2;
constexpr size_t WS_K = WS_Q + (size_t)MG * 1024 * 2;
constexpr size_t WS_KT = WS_K + (size_t)MG * 1024 * 2;
constexpr size_t WS_SG = WS_KT + (size_t)2 * KTROWS * KTLD * 2;
constexpr size_t WS_CONV = WS_SG + (size_t)MG * 2048 * 2;
constexpr size_t WS_GATES = WS_CONV + (size_t)MG * 3072 * 2;
constexpr size_t WS_ABUF = WS_GATES + (size_t)MG * 2048 * 2;
constexpr size_t WS_BBUF = WS_ABUF + (size_t)512 * 256 * 512 * 2;
constexpr size_t WS_END = WS_BBUF + (size_t)512 * 256 * 512 * 2;
constexpr size_t WS_O = WS_H;
constexpr size_t WS_Y = WS_ABUF;
constexpr size_t WS_MRG = WS_BBUF;
constexpr size_t WS_H2 = WS_BBUF + (size_t)MG * 1024 * 2;
constexpr size_t WS_U = WS_SG;
constexpr size_t SLOTB = (size_t)256 * 512 * 2;

constexpr int LDS_BYTES = 143360;
constexpr int XLD = 5120;

__device__ __forceinline__ unsigned cvtpk(float lo, float hi) { f32x2 v = {lo, hi}; bf16x2_t b = __builtin_convertvector(v, bf16x2_t); return __builtin_bit_cast(unsigned, b); }
__device__ __forceinline__ void store4(bf16_t* p, f32x4 v) { u32x2 w; w.x = cvtpk(v[0], v[1]); w.y = cvtpk(v[2], v[3]); *(GAS u32x2*)p = w; }
__device__ __forceinline__ f32x4 load4(const bf16_t* p) { const u32x2 w = *(const GAS u32x2*)p; f32x4 v; v[0] = __uint_as_float(w.x << 16); v[1] = __uint_as_float(w.x & 0xffff0000u); v[2] = __uint_as_float(w.y << 16); v[3] = __uint_as_float(w.y & 0xffff0000u); return v; }
__device__ __forceinline__ float sigmoidf_(float x) { return __builtin_amdgcn_rcpf(1.0f + __builtin_amdgcn_exp2f(x * -1.4426950408889634f)); }
__device__ __forceinline__ unsigned char* lw(unsigned char* p) { asm volatile("" : "+s"(p));
#if defined(__HIP_DEVICE_COMPILE__)
    __builtin_assume(!__builtin_amdgcn_is_shared(p)); __builtin_assume(!__builtin_amdgcn_is_private(p));
#endif
    return p; }
__device__ __forceinline__ float wave_sum(float v) {
#pragma unroll
    for (int o = 32; o > 0; o >>= 1) v += __shfl_xor(v, o);
    return v;
}


#define XB_TMO      128
#define XB_XCNT(j)  (256  + 64 * (j))
#define XB_XSUB(j)  (1280 + 64 * (j))
#define XB_XGEN(j)  (2304 + 64 * (j))
#define XB_TOP      3328
#define XB_TOPGEN   3392
#define XCD_BAR_WORDS 3456
#define XB_SPIN_CAP (1u << 22)
__device__ __forceinline__ unsigned xb_ld(unsigned* p)              { return __hip_atomic_load(p, __ATOMIC_RELAXED, __HIP_MEMORY_SCOPE_AGENT); }
__device__ __forceinline__ unsigned xb_add(unsigned* p, unsigned v) { return __hip_atomic_fetch_add(p, v, __ATOMIC_RELAXED, __HIP_MEMORY_SCOPE_AGENT); }
__device__ __forceinline__ unsigned xb_xcc_id() { return (unsigned)__builtin_amdgcn_s_getreg((3 << 11) | 20) & 0xFu; }
#define XB_SPIN(cond, bar) do { unsigned _sp = 0; while (cond) { __builtin_amdgcn_s_sleep(1); \
    if ((++_sp & 255u) == 0u) { if (xb_ld(&(bar)[XB_TMO])) break; if (_sp > XB_SPIN_CAP) { atomicAdd(&(bar)[XB_TMO], 1u); break; } } } } while (0)
struct XcdBarrier { unsigned* bar; unsigned x; volatile LAS unsigned* st; };
__device__ __forceinline__ XcdBarrier xcd_barrier_post(unsigned* bar, volatile LAS unsigned* st) {
    XcdBarrier b; b.bar = bar; b.x = xb_xcc_id(); b.st = st;
    if (threadIdx.x == 0) (void)xb_add(&bar[XB_XCNT(b.x)], 1u);
    return b;
}
__device__ __forceinline__ void xcd_barrier_complete(unsigned* bar, unsigned x, unsigned& nloc, unsigned& nx) {
    const unsigned G = gridDim.x * gridDim.y * gridDim.z;
    unsigned sum, cnt, mine, sp = 0u;
    for (;;) {
        sum = 0u; cnt = 0u; mine = 0u;
#pragma unroll
        for (unsigned j = 0; j < 16; ++j) { const unsigned c = xb_ld(&bar[XB_XCNT(j)]); sum += c; cnt += (c > 0u) ? 1u : 0u; mine = (j == x) ? c : mine; }
        if (sum == G) break;
        __builtin_amdgcn_s_sleep(1);
        if ((++sp & 255u) == 0u) { if (xb_ld(&bar[XB_TMO])) break; if (sp > XB_SPIN_CAP) { atomicAdd(&bar[XB_TMO], 1u); break; } }
    }
    nloc = mine > 0u ? mine : 1u; nx = cnt > 0u ? cnt : 1u;
}
__device__ __forceinline__ void xcd_barrier(const XcdBarrier& b) {
    asm volatile("s_waitcnt vmcnt(0)" ::: "memory");
    __syncthreads();
    if (threadIdx.x == 0) {
        unsigned* bar = b.bar; unsigned bx = b.x; asm volatile("" : "+s"(bar), "+s"(bx));
        __builtin_amdgcn_s_waitcnt(0);
        unsigned nloc = b.st[0], nx = b.st[1];
        if (nloc == 0u) { xcd_barrier_complete(bar, bx, nloc, nx); b.st[0] = nloc; b.st[1] = nx; }
        const unsigned old = xb_add(&bar[XB_XSUB(bx)], 1u);
        const unsigned gen = old / nloc;
        if (old + 1u == (gen + 1u) * nloc) {
            __builtin_amdgcn_fence(__ATOMIC_RELEASE, "agent");
            asm volatile("s_waitcnt vmcnt(0)" ::: "memory");
            const unsigned og = xb_add(&bar[XB_TOP], 1u);
            const unsigned tg = og / nx;
            if (og + 1u == (tg + 1u) * nx) xb_add(&bar[XB_TOPGEN], 1u);
            else XB_SPIN(xb_ld(&bar[XB_TOPGEN]) == tg, bar);
            __builtin_amdgcn_fence(__ATOMIC_ACQUIRE, "agent");
            xb_add(&bar[XB_XGEN(bx)], 1u);
            asm volatile("s_waitcnt vmcnt(0)" ::: "memory");
        } else {
            XB_SPIN(xb_ld(&bar[XB_XGEN(bx)]) == gen, bar);
            __builtin_amdgcn_fence(__ATOMIC_ACQUIRE, "agent");
            asm volatile("s_waitcnt vmcnt(0)" ::: "memory");
        }
    }
    __syncthreads();
}

namespace pg8 {
constexpr int BM = 256, BK = 64, HALF = 128, HTB = HALF * BK * 2;
__device__ __forceinline__ int lds_byte(int r, int c) { const int st = (r >> 4) * 2 + (c >> 5), rr = r & 15, cc = c & 31, ob = rr * 64 + cc * 2; return st * 1024 + (ob ^ (((ob >> 9) & 1) << 5)); }
__device__ __forceinline__ void stage_rc(int b, int& R, int& C) { const int st = b / 1024, sb = b % 1024, swz = sb ^ (((sb >> 9) & 1) << 5); R = (st >> 1) * 16 + swz / 64; C = (st & 1) * 32 + (swz % 64) / 2; }

struct Unit { const char* A; const char* B; int pm, pn, f; float sc; };
typedef f32x4 Acc[2][2][4][2];

struct Order2D {
    int nM, nN, nwg, G, c;
    __device__ void init(int nM_, int nN_, int G_, int c_) { nM = nM_; nN = nN_; nwg = nM * nN; G = G_; c = c_; }
    __device__ bool get(int i, int& pm, int& pn) const {
        const long L = (long)i * G + c; if (L >= nwg) return false;
        int wgid = (int)L; { const int q = nwg / 8, r = nwg % 8, xcd = wgid % 8, off = wgid / 8; wgid = (xcd < r ? xcd * (q + 1) : r * (q + 1) + (xcd - r) * q) + off; }
        const int nig = 8 * nN, gid = wgid / nig, fm = gid * 8, gsz = (nM - fm) < 8 ? (nM - fm) : 8;
        pm = fm + ((wgid % nig) % gsz); pn = (wgid % nig) / gsz; return true;
    }
};

template <class Epi, class Sched>
__device__ __forceinline__ void gemm_phase(LAS unsigned char* lds, const int lda, const int ldb, const int K, const Sched& S, const Epi& E) {
    int tid_ = threadIdx.x; asm volatile("" : "+v"(tid_));
    const int tid = tid_, wid = __builtin_amdgcn_readfirstlane(tid >> 6), lane = tid & 63, wr = wid >> 2, wc = wid & 3, fr = lane & 15, fq = lane >> 4;
    const int nt = K / BK;
    unsigned voffA[2], voffB[2];
#pragma unroll
    for (int i = 0; i < 2; ++i) { int R, C; stage_rc(tid * 16 + i * 8192, R, C); const int rho = R & 31; const int Rb = Epi::PERM ? ((R & ~31) + 8 * ((rho & 15) >> 2) + 4 * (rho >> 4) + (rho & 3)) : R;
        voffA[i] = (unsigned)(R * lda + C) * 2u; voffB[i] = (unsigned)(Rb * ldb + C) * 2u; }
    const size_t kstep = (size_t)(BK * 2);
    const size_t hstepA = (size_t)HALF * lda * 2, hstepB = (size_t)HALF * ldb * 2;
    const unsigned ldsw = (unsigned)wid * 1024u;
    const int aoff = lds_byte(wr * 64 + fr, fq * 8), boff = lds_byte(wc * 32 + fr, fq * 8);
#define PG8_SA(b, h) (((b) * 2 + (h)) * HTB)
#define PG8_SB(b, h) ((4 + (b) * 2 + (h)) * HTB)
#define PG8_STAGE(bufoff, gbase, voff) do { _Pragma("unroll") for (int _i = 0; _i < 2; ++_i) \
        __builtin_amdgcn_global_load_lds((const unsigned*)((const char*)(gbase) + (voff)[_i]), (LAS unsigned*)(lds + (bufoff) + ldsw + _i * 8192), 16, 0, 0); } while (0)
#define PG8_LDA(dst, b, h) do { _Pragma("unroll") for (int m = 0; m < 4; ++m) _Pragma("unroll") for (int k = 0; k < 2; ++k) dst[m][k] = *(const LAS bf16x8*)(lds + PG8_SA(b, h) + aoff + m * 2048 + k * 1024); } while (0)
#define PG8_LDB(dst, b, h) do { _Pragma("unroll") for (int n = 0; n < 2; ++n) _Pragma("unroll") for (int k = 0; k < 2; ++k) dst[n][k] = *(const LAS bf16x8*)(lds + PG8_SB(b, h) + boff + n * 2048 + k * 1024); } while (0)
#define PG8_MMA(ai, bj, At, Bt) do { __builtin_amdgcn_s_setprio(1); _Pragma("unroll") for (int m = 0; m < 4; ++m) _Pragma("unroll") for (int n = 0; n < 2; ++n) _Pragma("unroll") for (int k = 0; k < 2; ++k) \
        acc[ai][bj][m][n] = __builtin_amdgcn_mfma_f32_16x16x32_bf16(Bt[n][k], At[m][k], acc[ai][bj][m][n], 0, 0, 0); __builtin_amdgcn_s_setprio(0); } while (0)
#define PG8_MMA1(ai, At) do { if constexpr (!Epi::HALF_N) PG8_MMA(ai, 1, At, B1); } while (0)
#define PG8_WAIT_V(n) asm volatile("s_waitcnt vmcnt(" #n ")" ::: "memory")
#define PG8_WAIT_L(n) asm volatile("s_waitcnt lgkmcnt(" #n ")" ::: "memory")
#define PG8_BAR __builtin_amdgcn_s_barrier()
#define PG8_SCHED __builtin_amdgcn_sched_barrier(0)
    Unit cur, nxt; int ui = 0;
    if (!S.next(0, cur)) return;
    Acc acc;
#pragma unroll
    for (int a = 0; a < 2; ++a)
#pragma unroll
        for (int b = 0; b < 2; ++b)
#pragma unroll
            for (int m = 0; m < 4; ++m)
#pragma unroll
                for (int n = 0; n < 2; ++n) acc[a][b][m][n] = (f32x4){0.f, 0.f, 0.f, 0.f};
    bf16x8 At[4][2], B0[2][2], B1[2][2];
    const char* cA = cur.A; const char* cB = cur.B;
#define PG8_STAGE_B1(bufoff, gbase) do { if constexpr (!Epi::HALF_N) PG8_STAGE(bufoff, gbase, voffB); } while (0)
#define PG8_LDB1(dst, b) do { if constexpr (!Epi::HALF_N) PG8_LDB(dst, b, 1); } while (0)
#define PG8_WAIT_VL do { if constexpr (Epi::HALF_N) PG8_WAIT_V(6); else PG8_WAIT_V(8); } while (0)
    PG8_STAGE(PG8_SB(0, 0), cB, voffB); PG8_STAGE_B1(PG8_SB(0, 1), cB + hstepB); PG8_STAGE(PG8_SA(0, 0), cA, voffA); PG8_STAGE(PG8_SA(0, 1), cA + hstepA, voffA);
    if (wr == 1) PG8_BAR;
    PG8_WAIT_V(2); PG8_BAR;
    PG8_STAGE(PG8_SB(1, 0), cB + kstep, voffB); PG8_STAGE(PG8_SA(1, 0), cA + kstep, voffA); PG8_STAGE_B1(PG8_SB(1, 1), cB + hstepB + kstep);
    if constexpr (Epi::HALF_N) PG8_WAIT_V(4); else PG8_WAIT_V(6);
    PG8_BAR;
    for (;;) {
        const bool has_next = S.next(ui + 1, nxt);
        const char* nA = has_next ? nxt.A : cA; const char* nB = has_next ? nxt.B : cB;
        for (int t = 0; t < nt; t += 2) {
            const bool last = (t == nt - 2);
            const char* a1 = cA + (size_t)(t + 1) * kstep;
            const char* a2 = last ? nA : cA + (size_t)(t + 2) * kstep; const char* b2 = last ? nB : cB + (size_t)(t + 2) * kstep;
            const char* a3 = a2 + kstep; const char* b3 = b2 + kstep;
            if constexpr (Epi::HAS_MID) { if (t == E.mid_t) { int fr2 = fr, fq2 = fq; asm volatile("" : "+v"(fr2), "+v"(fq2)); E.mid(acc, cur, wr, wc, fr2, fq2); } }
            PG8_LDB(B0, 0, 0); PG8_LDB1(B1, 0); PG8_SCHED; PG8_LDA(At, 0, 0); PG8_STAGE(PG8_SA(1, 1), a1 + hstepA, voffA);
            PG8_WAIT_VL; PG8_WAIT_L(0); PG8_BAR; PG8_MMA(0, 0, At, B0); PG8_MMA1(0, At); PG8_BAR; PG8_SCHED;
            PG8_LDA(At, 0, 1); PG8_STAGE(PG8_SB(0, 0), b2, voffB); PG8_STAGE_B1(PG8_SB(0, 1), b2 + hstepB); PG8_STAGE(PG8_SA(0, 0), a2, voffA);
            PG8_WAIT_VL; PG8_WAIT_L(0); PG8_BAR; PG8_MMA(1, 0, At, B0); PG8_MMA1(1, At); PG8_BAR; PG8_SCHED;
            PG8_LDB(B0, 1, 0); PG8_LDB1(B1, 1); PG8_SCHED; PG8_LDA(At, 1, 0); PG8_STAGE(PG8_SA(0, 1), a2 + hstepA, voffA);
            PG8_WAIT_VL; PG8_WAIT_L(0); PG8_BAR; PG8_MMA(0, 0, At, B0); PG8_MMA1(0, At); PG8_BAR; PG8_SCHED;
            PG8_LDA(At, 1, 1); PG8_STAGE(PG8_SB(1, 0), b3, voffB); PG8_STAGE_B1(PG8_SB(1, 1), b3 + hstepB); PG8_STAGE(PG8_SA(1, 0), a3, voffA);
            PG8_WAIT_VL; PG8_WAIT_L(0); PG8_BAR; PG8_MMA(1, 0, At, B0); PG8_MMA1(1, At); PG8_BAR; PG8_SCHED;
        }
        if (wr == 0) PG8_BAR;
        { int fr2 = fr, fq2 = fq; asm volatile("" : "+v"(fr2), "+v"(fq2)); E(acc, cur, wr, wc, fr2, fq2); }
        if (!has_next) break;
        if (Epi::CARRY && !(nxt.f & 1)) {
            const float s = nxt.sc;
#pragma unroll
            for (int a = 0; a < 2; ++a)
#pragma unroll
                for (int b = 0; b < 2; ++b)
#pragma unroll
                    for (int m = 0; m < 4; ++m)
#pragma unroll
                        for (int n = 0; n < 2; ++n) acc[a][b][m][n] = acc[a][b][m][n] * s;
        } else {
#pragma unroll
            for (int a = 0; a < 2; ++a)
#pragma unroll
                for (int b = 0; b < 2; ++b)
#pragma unroll
                    for (int m = 0; m < 4; ++m)
#pragma unroll
                        for (int n = 0; n < 2; ++n) acc[a][b][m][n] = (f32x4){0.f, 0.f, 0.f, 0.f};
        }
        cur = nxt; cA = nA; cB = nB; ++ui;
        if (wr == 1) PG8_BAR;
    }
    PG8_WAIT_V(0);
    PG8_BAR;
#undef PG8_SA
#undef PG8_SB
#undef PG8_STAGE
#undef PG8_LDA
#undef PG8_LDB
#undef PG8_MMA
#undef PG8_MMA1
#undef PG8_STAGE_B1
#undef PG8_LDB1
#undef PG8_WAIT_VL
#undef PG8_WAIT_V
#undef PG8_WAIT_L
#undef PG8_BAR
#undef PG8_SCHED
}
}
using pg8::Unit; using pg8::Acc;

#define EPI_FLAGS(hm_, carry_, halfn_, perm_) static constexpr bool HAS_MID = hm_, CARRY = carry_, HALF_N = halfn_, PERM = perm_; int mid_t; \
    __device__ __forceinline__ void mid(Acc&, const Unit&, int, int, int, int) const {}
#define FOR_AI_M _Pragma("unroll") for (int ai = 0; ai < 2; ++ai) _Pragma("unroll") for (int m = 0; m < 4; ++m)
#define FOR_BJ _Pragma("unroll") for (int bj = 0; bj < 2; ++bj)
__device__ __forceinline__ void store8(bf16_t* p, f32x4 a, f32x4 b) { u32x4 w; w.x = cvtpk(a[0], a[1]); w.y = cvtpk(a[2], a[3]); w.z = cvtpk(b[0], b[1]); w.w = cvtpk(b[2], b[3]); *(GAS u32x4*)p = w; }
__device__ __forceinline__ void load8(const bf16_t* p, f32x4& a, f32x4& b) { const u32x4 w = *(const GAS u32x4*)p;
    a[0] = __uint_as_float(w.x << 16); a[1] = __uint_as_float(w.x & 0xffff0000u); a[2] = __uint_as_float(w.y << 16); a[3] = __uint_as_float(w.y & 0xffff0000u);
    b[0] = __uint_as_float(w.z << 16); b[1] = __uint_as_float(w.z & 0xffff0000u); b[2] = __uint_as_float(w.w << 16); b[3] = __uint_as_float(w.w & 0xffff0000u); }
__device__ __forceinline__ f32x4 sig4(f32x4 v) { f32x4 r; r[0] = sigmoidf_(v[0]); r[1] = sigmoidf_(v[1]); r[2] = sigmoidf_(v[2]); r[3] = sigmoidf_(v[3]); return r; }

struct EpiNat {
    EPI_FLAGS(false, false, false, false)
    bf16_t *q, *sg, *abuf, *kft; const float *cosT, *sinT, *l2g; int nch, rope;
    __device__ __forceinline__ void operator()(Acc& acc, const Unit& u, int wr, int wc, int fr, int fq) const {
        const int pn = u.pn;
        if (pn < 8) {
            const bool isq = pn < 4; bf16_t* dst = q + (isq ? (size_t)0 : (size_t)MG * 1024);
            const int head = 2 * (pn & 3) + (wc >> 1), type = wc & 1, i0 = 8 * fq, dbase = (type ? 64 : 0) + i0;
            const float lf = l2g[head], lb = l2g[8 + head];
            FOR_AI_M {
                const int r = 128 * ai + 64 * wr + 16 * m + fr; const size_t R = (size_t)u.pm * 256 + r;
                f32x4 cs0 = {1.f, 1.f, 1.f, 1.f}, cs1 = cs0, sn0 = {0.f, 0.f, 0.f, 0.f}, sn1 = sn0;
                if (rope) { const int t = (int)(R & 2047); const int pos = type ? (t & 63) : (t >> 6);
                    cs0 = *(const GAS f32x4*)(cosT + pos * 32 + i0); cs1 = *(const GAS f32x4*)(cosT + pos * 32 + i0 + 4); sn0 = *(const GAS f32x4*)(sinT + pos * 32 + i0); sn1 = *(const GAS f32x4*)(sinT + pos * 32 + i0 + 4); }
                const f32x4 a0 = acc[ai][0][m][0], a1 = acc[ai][0][m][1], b0 = acc[ai][1][m][0], b1 = acc[ai][1][m][1];
                const f32x4 o10 = a0 * cs0 - b0 * sn0, o11 = a1 * cs1 - b1 * sn1, o20 = a0 * sn0 + b0 * cs0, o21 = a1 * sn1 + b1 * cs1;
                if (!isq) { bf16_t* rowp = dst + R * 1024 + head * 128 + dbase; store8(rowp, o10, o11); store8(rowp + 32, o20, o21); }
                if (!isq) {
                    const float wkf = __builtin_amdgcn_exp2f(lf * (float)(255 - r)), wkb = __builtin_amdgcn_exp2f(lb * (float)r);
                    GAS unsigned short* kp = (GAS unsigned short*)(kft + ((size_t)u.pm * KTROWS + head * 128 + dbase) * 256 + r);
                    GAS unsigned short* kq = kp + (size_t)64 * KTROWS * 256;
                    const int cch = u.pm % nch; const bool wrf = !(rope && cch == nch - 1), wrb = !(rope && cch == 0);
                    if (wrf) {
#pragma unroll
                        for (int j = 0; j < 4; ++j) {
                            kp[(size_t)j * 256] = (unsigned short)cvtpk(o10[j] * wkf, 0.f); kp[(size_t)(4 + j) * 256] = (unsigned short)cvtpk(o11[j] * wkf, 0.f);
                            kp[(size_t)(32 + j) * 256] = (unsigned short)cvtpk(o20[j] * wkf, 0.f); kp[(size_t)(36 + j) * 256] = (unsigned short)cvtpk(o21[j] * wkf, 0.f); } }
                    if (wrb) {
#pragma unroll
                        for (int j = 0; j < 4; ++j) {
                            kq[(size_t)j * 256] = (unsigned short)cvtpk(o10[j] * wkb, 0.f); kq[(size_t)(4 + j) * 256] = (unsigned short)cvtpk(o11[j] * wkb, 0.f);
                            kq[(size_t)(32 + j) * 256] = (unsigned short)cvtpk(o20[j] * wkb, 0.f); kq[(size_t)(36 + j) * 256] = (unsigned short)cvtpk(o21[j] * wkb, 0.f); } }
                }
                if (isq) {
                    const int slot = ((u.pm / nch) * 8 + head) * nch + (u.pm % nch);
                    const float wf = __builtin_amdgcn_exp2f(lf * (float)(r + 1)), wb = __builtin_amdgcn_exp2f(lb * (float)(256 - r));
                    bf16_t* ap = abuf + ((size_t)slot * 256 + r) * 512 + 256 + dbase;
                    store8(ap, o10 * wf, o11 * wf); store8(ap + 32, o20 * wf, o21 * wf); store8(ap + 128, o10 * wb, o11 * wb); store8(ap + 160, o20 * wb, o21 * wb);
                }
            }
        } else {
            size_t doff; int ld, c0, act;
            if (pn < 16) { doff = 0; ld = XLD; c0 = (pn - 8) * 256; act = 1; }
            else if (pn < 20) { doff = 0; ld = XLD; c0 = 2048 + (pn - 16) * 256; act = 0; }
            else if (pn < 28) {
                FOR_AI_M { const int r = 128 * ai + 64 * wr + 16 * m + fr; const size_t R = (size_t)u.pm * 256 + r;
                    store8(sg + R * XLD + 3072 + (pn - 20) * 128 + 32 * wc + 8 * fq, acc[ai][0][m][0] * acc[ai][1][m][0], acc[ai][0][m][1] * acc[ai][1][m][1]); }
                return;
            }
            else { doff = (size_t)MG * XLD; ld = 2048; c0 = (pn - 28) * 256; act = 2; }
            bf16_t* dst = sg + doff;
            FOR_AI_M {
                const int r = 128 * ai + 64 * wr + 16 * m + fr; const size_t R = (size_t)u.pm * 256 + r;
                FOR_BJ {
                    f32x4 v0 = acc[ai][bj][m][0], v1 = acc[ai][bj][m][1];
                    if (act == 1) { v0 = v0 * sig4(v0); v1 = v1 * sig4(v1); }
                    else if (act == 2) { v0 = sig4(v0); v1 = sig4(v1); }
                    store8(dst + R * ld + c0 + 128 * bj + 32 * wc + 8 * fq, v0, v1);
                }
            }
        }
    }
};

struct EpiKT {
    EPI_FLAGS(false, false, false, true)
    bf16_t *kft, *kbt; const float *cosT, *sinT, *cosT2, *sinT2, *l2g; int rope;
    __device__ __forceinline__ void operator()(Acc& acc, const Unit& u, int wr, int wc, int fr, int fq) const {
#pragma unroll
        for (int ai = 0; ai < 2; ++ai) {
            const int head = 2 * u.pm + ai; const float lf = l2g[head], lb = l2g[8 + head];
            FOR_BJ {
                const int c0 = 128 * bj + 32 * wc + 8 * fq;
                f32x4 wf0, wf1, wb0, wb1;
#pragma unroll
                for (int j = 0; j < 4; ++j) { wf0[j] = __builtin_amdgcn_exp2f(lf * (float)(255 - (c0 + j))); wf1[j] = __builtin_amdgcn_exp2f(lf * (float)(251 - (c0 + j))); wb0[j] = __builtin_amdgcn_exp2f(lb * (float)(c0 + j)); wb1[j] = __builtin_amdgcn_exp2f(lb * (float)(c0 + 4 + j)); }
#pragma unroll
                for (int mm = 0; mm < 2; ++mm) {
                    const int i = 16 * mm + fr;
                    f32x4 cs0 = {1.f, 1.f, 1.f, 1.f}, cs1 = cs0, sn0 = {0.f, 0.f, 0.f, 0.f}, sn1 = sn0;
                    if (rope) {
                        if (wr == 1) { const int pos0 = c0 & 63; cs0 = *(const GAS f32x4*)(cosT2 + i * 64 + pos0); cs1 = *(const GAS f32x4*)(cosT2 + i * 64 + pos0 + 4); sn0 = *(const GAS f32x4*)(sinT2 + i * 64 + pos0); sn1 = *(const GAS f32x4*)(sinT2 + i * 64 + pos0 + 4); }
                        else { const int pos = (((u.pn & 7) * 256 + c0) >> 6); const float c = cosT[pos * 32 + i], sv = sinT[pos * 32 + i]; cs0 = (f32x4){c, c, c, c}; cs1 = cs0; sn0 = (f32x4){sv, sv, sv, sv}; sn1 = sn0; }
                    }
                    const f32x4 a0 = acc[ai][bj][mm][0], a1 = acc[ai][bj][mm][1], b0 = acc[ai][bj][mm + 2][0], b1 = acc[ai][bj][mm + 2][1];
                    const f32x4 o10 = a0 * cs0 - b0 * sn0, o11 = a1 * cs1 - b1 * sn1, o20 = a0 * sn0 + b0 * cs0, o21 = a1 * sn1 + b1 * cs1;
                    const size_t row1 = (size_t)head * 128 + 64 * wr + 16 * mm + fr, row2 = row1 + 32;
                    const size_t tb = (size_t)u.pn * KTROWS;
                    store8(kft + (tb + row1) * 256 + c0, o10 * wf0, o11 * wf1); store8(kft + (tb + row2) * 256 + c0, o20 * wf0, o21 * wf1);
                    store8(kbt + (tb + row1) * 256 + c0, o10 * wb0, o11 * wb1); store8(kbt + (tb + row2) * 256 + c0, o20 * wb0, o21 * wb1);
                }
            }
        }
    }
};

struct EpiVT {
    EPI_FLAGS(false, false, false, true)
    bf16_t* bbuf; int nch;
    __device__ __forceinline__ void operator()(Acc& acc, const Unit& u, int wr, int wc, int fr, int fq) const {
        const int slot = ((u.pn / nch) * 8 + u.pm) * nch + (u.pn % nch);
        bf16_t* dst = bbuf + (size_t)slot * 256 * 512;
        FOR_AI_M { const int dv = 128 * ai + 64 * wr + 16 * m + fr;
            FOR_BJ store8(dst + (size_t)dv * 512 + 128 * bj + 32 * wc + 8 * fq, acc[ai][bj][m][0], acc[ai][bj][m][1]); }
    }
};

struct EpiKV {
    EPI_FLAGS(false, false, false, true)
    EpiKT kt; EpiVT vt;
    __device__ __forceinline__ void operator()(Acc& acc, const Unit& u, int wr, int wc, int fr, int fq) const {
        if (u.pm < 4) kt(acc, u, wr, wc, fr, fq);
        else { Unit v = u; v.pm = u.pm - 4; vt(acc, v, wr, wc, fr, fq); }
    }
};

struct EpiScores {
    EPI_FLAGS(false, false, false, true)
    bf16_t* abuf; const float* l2g;
    __device__ __forceinline__ void operator()(Acc& acc, const Unit& u, int wr, int wc, int fr, int fq) const {
        const float lf = l2g[u.pn], lb = l2g[8 + u.pn];
        bf16_t* dst = abuf + (size_t)u.pm * 256 * 512;
        FOR_AI_M { const int t = 128 * ai + 64 * wr + 16 * m + fr; const float rowe = -lf * (float)(t + 1);
            FOR_BJ { const int c0 = 128 * bj + 32 * wc + 8 * fq; f32x4 v0 = acc[ai][bj][m][0], v1 = acc[ai][bj][m][1];
#pragma unroll
                for (int j = 0; j < 4; ++j) {
                    const int d0 = t - (c0 + j), d1 = d0 - 4;
                    v0[j] *= __builtin_amdgcn_exp2f((d0 >= 0 ? lf : -lb) * (float)d0 + (d0 == 0 ? rowe + 1.0f : rowe));
                    v1[j] *= __builtin_amdgcn_exp2f((d1 >= 0 ? lf : -lb) * (float)d1 + (d1 == 0 ? rowe + 1.0f : rowe)); }
                store8(dst + (size_t)t * 512 + c0, v0, v1); } }
    }
};

struct EpiChain {
    EPI_FLAGS(false, true, true, true)
    bf16_t* bbuf;
    __device__ __forceinline__ void operator()(Acc& acc, const Unit& u, int wr, int wc, int fr, int fq) const {
        if (u.pm < 0) return;
        bf16_t* dst = bbuf + (size_t)u.pm * 256 * 512 + u.pn;
        FOR_AI_M { const int dv = 128 * ai + 64 * wr + 16 * m + fr;
            store8(dst + (size_t)dv * 512 + 32 * wc + 8 * fq, acc[ai][0][m][0], acc[ai][0][m][1]); }
    }
};

__device__ __forceinline__ void unpack8(const u32x4 w, f32x4& a, f32x4& b) {
    a[0] = __uint_as_float(w.x << 16); a[1] = __uint_as_float(w.x & 0xffff0000u); a[2] = __uint_as_float(w.y << 16); a[3] = __uint_as_float(w.y & 0xffff0000u);
    b[0] = __uint_as_float(w.z << 16); b[1] = __uint_as_float(w.z & 0xffff0000u); b[2] = __uint_as_float(w.w << 16); b[3] = __uint_as_float(w.w & 0xffff0000u); }
struct EpiO {
    EPI_FLAGS(false, false, false, true)
    bf16_t* xb; LAS unsigned char* xl; bf16_t* ob; int opitch;
    __device__ __forceinline__ void operator()(Acc& acc, const Unit& u, int wr, int wc, int fr, int fq) const {
        LAS f32x2* P = (LAS f32x2*)xl;
        bf16_t* obase = ob + ((size_t)u.f * 256 + 64 * wr + fr) * opitch + u.pn * 256 + 32 * wc + 8 * fq;
        bf16_t* base = xb + ((size_t)u.f * 256 + 64 * wr + fr) * XLD + u.pn * 256 + 32 * wc + 8 * fq;
        u32x4 gp[2][4][2];
        FOR_AI_M { FOR_BJ gp[ai][m][bj] = *(const GAS u32x4*)(base + (size_t)(128 * ai + 16 * m) * XLD + 128 * bj); }
        FOR_AI_M {
            float sm = 0.f;
            FOR_BJ { const f32x4 a = acc[ai][bj][m][0], b = acc[ai][bj][m][1]; sm += ((a[0] + a[1]) + (a[2] + a[3])) + ((b[0] + b[1]) + (b[2] + b[3])); }
            sm += __shfl_xor(sm, 16); sm += __shfl_xor(sm, 32);
            const float mw = sm * (1.0f / 64.0f); float qv = 0.f;
            FOR_BJ { const f32x4 a = acc[ai][bj][m][0] - mw, b = acc[ai][bj][m][1] - mw; qv += ((a[0] * a[0] + a[1] * a[1]) + (a[2] * a[2] + a[3] * a[3])) + ((b[0] * b[0] + b[1] * b[1]) + (b[2] * b[2] + b[3] * b[3])); }
            qv += __shfl_xor(qv, 16); qv += __shfl_xor(qv, 32);
            if (fq == 0) P[(128 * ai + 64 * wr + 16 * m + fr) * 4 + wc] = (f32x2){mw, qv};
        }
        asm volatile("s_waitcnt lgkmcnt(0)" ::: "memory"); __builtin_amdgcn_s_barrier(); asm volatile("" ::: "memory");
        FOR_AI_M {
            const int r = 128 * ai + 64 * wr + 16 * m + fr;
            const f32x2 p0 = P[r * 4 + 0], p1 = P[r * 4 + 1], p2 = P[r * 4 + 2], p3 = P[r * 4 + 3];
            const float mt = ((p0.x + p1.x) + (p2.x + p3.x)) * 0.25f;
            const float d0 = p0.x - mt, d1 = p1.x - mt, d2 = p2.x - mt, d3 = p3.x - mt;
            const float m2 = ((p0.y + p1.y) + (p2.y + p3.y)) + 64.0f * ((d0 * d0 + d1 * d1) + (d2 * d2 + d3 * d3));
            const float rs = rsqrtf(m2 * (1.0f / 256.0f) + EPS);
            FOR_BJ { f32x4 g0, g1; unpack8(gp[ai][m][bj], g0, g1);
                store8(obase + (size_t)(128 * ai + 16 * m) * opitch + 128 * bj, (acc[ai][bj][m][0] - mt) * rs * g0, (acc[ai][bj][m][1] - mt) * rs * g1); }
        }
        asm volatile("s_waitcnt lgkmcnt(0)" ::: "memory"); __builtin_amdgcn_s_barrier(); asm volatile("" ::: "memory");
    }
};

struct EpiMerge {
    static constexpr bool HAS_MID = true, CARRY = false, HALF_N = false, PERM = true; int mid_t;
    const bf16_t* gates; bf16_t* mrg;
    __device__ __forceinline__ void mid(Acc& acc, const Unit& u, int wr, int wc, int fr, int fq) const {
        FOR_AI_M { const size_t R = (size_t)u.pm * 256 + 128 * ai + 64 * wr + 16 * m + fr;
            FOR_BJ { const int col = u.pn * 256 + 128 * bj + 32 * wc + 8 * fq;
                f32x4 gr0, gr1, gc0, gc1; load8(gates + R * 2048 + col, gr0, gr1); load8(gates + R * 2048 + 1024 + col, gc0, gc1);
#pragma unroll
                for (int j = 0; j < 4; ++j) { acc[ai][bj][m][0][j] *= gr0[j] * __builtin_amdgcn_rcpf(gc0[j]); acc[ai][bj][m][1][j] *= gr1[j] * __builtin_amdgcn_rcpf(gc1[j]); } } }
    }
    __device__ __forceinline__ void operator()(Acc& acc, const Unit& u, int wr, int wc, int fr, int fq) const {
        FOR_AI_M { const size_t R = (size_t)u.pm * 256 + 128 * ai + 64 * wr + 16 * m + fr;
            FOR_BJ { const int col = u.pn * 256 + 128 * bj + 32 * wc + 8 * fq;
                f32x4 gc0, gc1; load8(gates + R * 2048 + 1024 + col, gc0, gc1);
                store8(mrg + R * 1024 + col, acc[ai][bj][m][0] * gc0, acc[ai][bj][m][1] * gc1); } }
    }
};

struct EpiRes {
    EPI_FLAGS(false, false, false, true)
    const float* xin; float* xout; const float* mod; int b0, ctx, which; const float* zero;
    __device__ __forceinline__ void operator()(Acc& acc, const Unit& u, int wr, int wc, int fr, int fq) const {
        const float* gv = zero ? zero - (size_t)u.pn * 256 : mod + (size_t)(ctx ? 32 : (b0 + (u.pm >> 3))) * 6144 + which * 1024;
        FOR_BJ { const int col = u.pn * 256 + 128 * bj + 32 * wc + 8 * fq; const f32x4 g0 = *(const GAS f32x4*)(gv + col), g1 = *(const GAS f32x4*)(gv + col + 4);
            FOR_AI_M { const size_t R = (size_t)u.pm * 256 + 128 * ai + 64 * wr + 16 * m + fr;
                const f32x4 x0 = *(const GAS f32x4*)(xin + R * 1024 + col), x1 = *(const GAS f32x4*)(xin + R * 1024 + col + 4);
                *(GAS f32x4*)(xout + R * 1024 + col) = x0 + g0 * acc[ai][bj][m][0]; *(GAS f32x4*)(xout + R * 1024 + col + 4) = x1 + g1 * acc[ai][bj][m][1]; } }
    }
};

struct EpiSwiglu {
    EPI_FLAGS(false, false, false, false)
    bf16_t* uo;
    __device__ __forceinline__ void operator()(Acc& acc, const Unit& u, int wr, int wc, int fr, int fq) const {
        FOR_AI_M { const size_t R = (size_t)u.pm * 256 + 128 * ai + 64 * wr + 16 * m + fr;
            const f32x4 g0 = acc[ai][0][m][0], g1 = acc[ai][0][m][1];
            store8(uo + R * DFF + u.pn * 128 + 32 * wc + 8 * fq, g0 * sig4(g0) * acc[ai][1][m][0], g1 * sig4(g1) * acc[ai][1][m][1]); }
    }
};

struct Sched2D {
    pg8::Order2D o; const char* A; const char* B; size_t sa, sb;
    __device__ bool next(int i, Unit& u) const { int pm, pn; if (!o.get(i, pm, pn)) return false; u.A = A + (size_t)pm * sa; u.B = B + (size_t)pn * sb; u.pm = pm; u.pn = pn; u.f = 1; u.sc = 0.f; return true; }
};
struct SchedSlots {
    int G, c, nslots, nch, mode; const char* A; const char* B;
    __device__ bool next(int i, Unit& u) const {
        const int slot = i * G + c; if (slot >= nslots) return false;
        const int bl = slot / (8 * nch), head = (slot / nch) & 7, ch = slot % nch, rowtile = bl * nch + ch;
        if (mode == 0) { u.A = A + (size_t)slot * SLOTB + 256 * 2; u.B = B + ((size_t)rowtile * 256 * 1024 + head * 128) * 2; }
        else { u.A = A + (size_t)slot * SLOTB; u.B = B + (size_t)slot * SLOTB; }
        u.pm = slot; u.pn = head; u.f = rowtile; u.sc = 0.f; return true;
    }
};
struct SchedChain {
    int G, c, b0; const char *cbb, *ckt, *bbuf, *kt; const float* l2g;
    __device__ bool next(int i, Unit& u) const {
        const int ch = c + (i >> 3) * G, step = i & 7; if (ch >= 128) return false;
        const int bl = ch >> 4, head = (ch >> 1) & 7, dir = ch & 1;
        const size_t dirb = (size_t)dir * 64 * KTROWS * 256 * 2, hb_ = (size_t)head * 128 * 256 * 2;
        if (step == 0) {
            u.A = cbb + (size_t)((b0 + bl) * 8 + head) * SLOTB; u.B = ckt + dirb + (size_t)(b0 + bl) * KTROWS * 256 * 2 + hb_;
            u.pm = (bl * 8 + head) * 8 + (dir ? 7 : 0);
        } else {
            const int cc = dir ? 8 - step : step - 1;
            u.A = bbuf + (size_t)((bl * 8 + head) * 8 + cc) * SLOTB; u.B = kt + dirb + (size_t)(bl * 8 + cc) * KTROWS * 256 * 2 + hb_;
            u.pm = (bl * 8 + head) * 8 + (dir ? cc - 1 : cc + 1);
        }
        u.pn = dir ? 384 : 256; u.f = (step == 0); u.sc = exp2f(256.0f * l2g[dir * 8 + head]);
        return true;
    }
};

struct Args { const float* in[17]; float* out; unsigned char* ws; };
enum { I_X = 0, I_C, I_CTX, I_CCTX, I_NMW, I_ADAW, I_ADAB, I_WIN, I_DECAY, I_CONVW, I_WRO, I_WCO, I_WO, I_NFW, I_WFI, I_WFO, I_FNW };

__device__ __forceinline__ void norm_mod_phase(const float* x, int nrows, const float* nw, const float* mod, int b0, int ctx, int sidx, bf16_t* dst) {
    int lane_ = threadIdx.x & 63; asm volatile("" : "+v"(lane_)); const int lane = lane_, gw = blockIdx.x * 8 + __builtin_amdgcn_readfirstlane(threadIdx.x >> 6), stride = gridDim.x * 8;
    for (int pr = gw; pr < nrows / 2; pr += stride) {
        const int row = 2 * pr;
        const float* sh = mod + (size_t)(ctx ? 32 : b0 + (row >> 11)) * 6144 + sidx * 1024; const float* sc = sh + 1024;
        const float* xr = x + (size_t)row * 1024;
        f32x4 v[4], u[4]; float ss = 0.f, st = 0.f;
#pragma unroll
        for (int q = 0; q < 4; ++q) { v[q] = *(const GAS f32x4*)(xr + q * 256 + lane * 4); u[q] = *(const GAS f32x4*)(xr + 1024 + q * 256 + lane * 4); }
#pragma unroll
        for (int q = 0; q < 4; ++q) { ss += v[q][0] * v[q][0] + v[q][1] * v[q][1] + v[q][2] * v[q][2] + v[q][3] * v[q][3]; st += u[q][0] * u[q][0] + u[q][1] * u[q][1] + u[q][2] * u[q][2] + u[q][3] * u[q][3]; }
#pragma unroll
        for (int o = 32; o > 0; o >>= 1) { ss += __shfl_xor(ss, o); st += __shfl_xor(st, o); }
        const float rs = rsqrtf(ss * (1.0f / 1024.0f) + EPS), rt = rsqrtf(st * (1.0f / 1024.0f) + EPS);
#pragma unroll
        for (int q = 0; q < 4; ++q) { const int c = q * 256 + lane * 4;
            const f32x4 w4 = *(const GAS f32x4*)(nw + c), s4 = *(const GAS f32x4*)(sc + c) + 1.0f, h4 = *(const GAS f32x4*)(sh + c);
            store4(dst + (size_t)row * 1024 + c, (v[q] * rs * w4) * s4 + h4);
            store4(dst + (size_t)(row + 1) * 1024 + c, (u[q] * rt * w4) * s4 + h4); }
    }
}
__device__ __forceinline__ void conv_phase(bf16_t* xbuf, const float* convw, int nrows, int seqmask, int wg0, int nwg, bf16_t* dbase, int dpitch) {
    int lane_ = threadIdx.x & 63; asm volatile("" : "+v"(lane_)); const int lane = lane_, gw = ((int)blockIdx.x - wg0) * 8 + __builtin_amdgcn_readfirstlane(threadIdx.x >> 6), stride = nwg * 8;
    for (int pr = gw; pr < nrows / 2; pr += stride) {
        const int row = 2 * pr, t = row & seqmask;
        const bf16_t* cr = xbuf + (size_t)row * XLD + 2048 + lane * 8;
        u32x4 cbA[2], cbB[2], wP[2], wA[2], wB[2], wN[2];
        const bool hp = t > 0, hn = t + 1 < seqmask;
#pragma unroll
        for (int q = 0; q < 2; ++q) {
            cbA[q] = *(const GAS u32x4*)(cr + q * 512); cbB[q] = *(const GAS u32x4*)(cr + XLD + q * 512);
            wA[q] = *(const GAS u32x4*)(cr + 1024 + q * 512); wB[q] = *(const GAS u32x4*)(cr + XLD + 1024 + q * 512);
            wP[q] = (u32x4){0u, 0u, 0u, 0u}; wN[q] = wP[q];
            if (hp) wP[q] = *(const GAS u32x4*)(cr - XLD + 1024 + q * 512);
            if (hn) wN[q] = *(const GAS u32x4*)(cr + 2 * XLD + 1024 + q * 512);
        }
#pragma unroll
        for (int q = 0; q < 2; ++q) { const float* wp = convw + q * 512 + lane * 8;
            const f32x4 w00 = *(const GAS f32x4*)(wp), w01 = *(const GAS f32x4*)(wp + 4), w10 = *(const GAS f32x4*)(wp + 1024), w11 = *(const GAS f32x4*)(wp + 1028), w20 = *(const GAS f32x4*)(wp + 2048), w21 = *(const GAS f32x4*)(wp + 2052);
            f32x4 p0, p1, x0, x1, y0, y1, n0, n1, c0, c1, d0, d1;
            unpack8(wP[q], p0, p1); unpack8(wA[q], x0, x1); unpack8(wB[q], y0, y1); unpack8(wN[q], n0, n1);
            unpack8(cbA[q], c0, c1); unpack8(cbB[q], d0, d1);
            bf16_t* dr = dbase + (size_t)row * dpitch + lane * 8;
            store8(dr + q * 512, c0 * (p0 * w00 + x0 * w10 + y0 * w20), c1 * (p1 * w01 + x1 * w11 + y1 * w21));
            store8(dr + dpitch + q * 512, d0 * (x0 * w00 + y0 * w10 + n0 * w20), d1 * (x1 * w01 + y1 * w11 + n1 * w21)); }
    }
}
__device__ __forceinline__ void final_norm_phase(float* x, int nrows, const float* nw) {
    int lane_ = threadIdx.x & 63; asm volatile("" : "+v"(lane_)); const int lane = lane_, gw = blockIdx.x * 8 + __builtin_amdgcn_readfirstlane(threadIdx.x >> 6), stride = gridDim.x * 8;
    for (int qr = gw; qr < nrows / 4; qr += stride) {
        float* xr = x + (size_t)qr * 4096; f32x4 v[4][4]; float ss[4];
#pragma unroll
        for (int r = 0; r < 4; ++r)
#pragma unroll
            for (int q = 0; q < 4; ++q) v[r][q] = *(const GAS f32x4*)(xr + r * 1024 + q * 256 + lane * 4);
#pragma unroll
        for (int r = 0; r < 4; ++r) { ss[r] = 0.f;
#pragma unroll
            for (int q = 0; q < 4; ++q) ss[r] += v[r][q][0] * v[r][q][0] + v[r][q][1] * v[r][q][1] + v[r][q][2] * v[r][q][2] + v[r][q][3] * v[r][q][3]; }
#pragma unroll
        for (int o = 32; o > 0; o >>= 1) {
#pragma unroll
            for (int r = 0; r < 4; ++r) ss[r] += __shfl_xor(ss[r], o); }
#pragma unroll
        for (int q = 0; q < 4; ++q) { const int c = q * 256 + lane * 4; const f32x4 w4 = *(const GAS f32x4*)(nw + c);
#pragma unroll
            for (int r = 0; r < 4; ++r) *(GAS f32x4*)(xr + r * 1024 + c) = v[r][q] * rsqrtf(ss[r] * (1.0f / 1024.0f) + EPS) * w4; }
    }
}

__device__ __forceinline__ int lane_col(int e) { return 32 * (e >> 5) + 16 * ((e >> 2) & 1) + 4 * ((e >> 3) & 3) + (e & 3); }
__device__ __forceinline__ int rope_perm(int n) { const int head = n >> 7, d = n & 127, x2 = (d >> 5) & 1, e = 64 * (head & 1) + (d < 64 ? 0 : 32) + (d & 31); return (head >> 1) * 256 + 128 * x2 + lane_col(e); }
__device__ __forceinline__ int nat8_perm(int c) { return (c & ~127) + lane_col(c & 127); }
__device__ __forceinline__ int ccu_perm(int n) { const int cu = n >> 10, ch = n & 1023; return (ch >> 7) * 256 + 128 * cu + lane_col(ch & 127); }
__device__ __forceinline__ int swiglu_perm(int c) { const int up = c >= DFF, f = c - DFF * up, tile = f >> 7, u = f & 127; return tile * 256 + 128 * up + lane_col(u); }
struct ConvJob { const float* src; int ldsrc, K, c0, ncol; bf16_t* dst; int lddst, dcol0, row0, perm; float scale; };
__device__ __forceinline__ void convert_job(const ConvJob& J, float* tl  ) {
    const int tid = threadIdx.x, nkt = J.K / 128, nnt = J.ncol / 128, ntile = nkt * nnt;
    for (int tile = blockIdx.x; tile < ntile; tile += gridDim.x) {
        const int k0 = (tile % nkt) * 128, n0 = (tile / nkt) * 128;
        { const int tx = tid & 127, ty = tid >> 7;
          float v[32];
#pragma unroll
          for (int p = 0; p < 32; ++p) v[p] = J.src[(size_t)(k0 + ty + 4 * p) * J.ldsrc + J.c0 + n0 + tx];
#pragma unroll
          for (int p = 0; p < 32; ++p) tl[(ty + 4 * p) * 129 + tx] = v[p]; }
        __syncthreads();
#pragma unroll
        for (int h = 0; h < 4; ++h) {
          const int n = (tid >> 4) + 32 * h, kq = tid & 15; const int nl = n0 + n;
          const int prow = J.perm == 1 ? rope_perm(nl) : (J.perm == 2 ? swiglu_perm(nl) : (J.perm == 3 ? nat8_perm(nl) : (J.perm == 5 ? ccu_perm(nl) : nl)));
          u32x4 w; float v[8];
#pragma unroll
          for (int jj = 0; jj < 8; ++jj) v[jj] = tl[(kq * 8 + jj) * 129 + n] * J.scale;
          w.x = cvtpk(v[0], v[1]); w.y = cvtpk(v[2], v[3]); w.z = cvtpk(v[4], v[5]); w.w = cvtpk(v[6], v[7]);
          *(GAS u32x4*)(J.dst + (size_t)(J.row0 + prow) * J.lddst + J.dcol0 + k0 + kq * 8) = w; }
        __syncthreads();
    }
}

__device__ __forceinline__ void e1_phase(const Args& a, unsigned char* ws0, int l, int g) {
    unsigned char* ws = lw(ws0);
    const int ctx = g < 0;
    const float* xin = ctx ? (l == 0 ? a.in[I_CTX] : (const float*)(ws + WS_XC)) : ((l == 0 ? a.in[I_X] : (const float*)a.out) + (size_t)g * MG * 1024);
    norm_mod_phase(xin, ctx ? MC : MG, a.in[I_NMW] + l * 1024, (const float*)(ws + WS_MOD) + (size_t)l * 33 * 6144, ctx ? 0 : g * GB, ctx, 0, (bf16_t*)(ws + WS_H));
}
#ifndef PHM
#define PHM 0xFFFF
#endif
#ifndef DUPM
#define DUPM 0
#endif
#define REP(bit) for (int rep_ = 0; rep_ <= ((DUPM >> (bit)) & 1); ++rep_)
__global__ void __launch_bounds__(512, 2) mega_fwd(Args a) {
    extern __shared__ __attribute__((aligned(16))) unsigned char lds_raw[];
    LAS unsigned char* lds = (LAS unsigned char*)lds_raw;
    cg::grid_group grid = cg::this_grid();
    unsigned char* ws = a.ws;
    const int G = gridDim.x, cid = blockIdx.x, tid = threadIdx.x;
    float* sc = (float*)(ws + WS_SC); float* l2g_all = (float*)(ws + WS_L2G);
    float* cosT_ = (float*)(ws + WS_ROPE); float* sinT_ = cosT_ + 2048; float* cosT2_ = cosT_ + 4096; float* sinT2_ = cosT_ + 6144;
    float* mod_all = (float*)(ws + WS_MOD);

    {
        const int gt = cid * 512 + tid, gs = G * 512;
        if (cid == 0) { unsigned* bw = (unsigned*)(ws + WS_BAR); for (int i = tid; i < XCD_BAR_WORDS; i += 512) bw[i] = 0u; }
        if (cid == 1) { float* zv = (float*)(ws + WS_ZERO); for (int i = tid; i < 1024; i += 512) zv[i] = 0.f; }
        for (int i = gt; i < 33 * 1024; i += gs) { const float v = (i < 32 * 1024) ? a.in[I_C][i] : a.in[I_CCTX][i - 32 * 1024]; sc[i] = v / (1.0f + expf(-v)); }
        if (gt < 32) { const float xl = a.in[I_DECAY][gt]; l2g_all[gt] = -log1pf(expf(-xl)) * 1.4426950408889634f; }
        for (int i = gt; i < 2048; i += gs) { const int pos = i >> 5, fi = i & 31; const float fr_ = exp2f(-(float)fi * (13.287712379549449f / 32.0f)); const float ang = (float)pos * fr_;
            const float c = cosf(ang), s = sinf(ang); cosT_[pos * 32 + fi] = c; sinT_[pos * 32 + fi] = s; cosT2_[fi * 64 + pos] = c; sinT2_[fi * 64 + pos] = s; }
        float* tl = (float*)lds_raw;
        REP(8) for (int l = 0; l < 2; ++l) {
            bf16_t* wnat = (bf16_t*)(ws + WS_WNAT) + (size_t)l * NNAT * 1024;
            const float* win = a.in[I_WIN] + (size_t)l * 1024 * 11264;
            const float ks = 0.08838834764831845f;
            const ConvJob jobs[13] = {
                {win, 11264, 1024, 0, 1024, wnat, 1024, 0, 0, 1, 1.0f},
                {win, 11264, 1024, 1024, 1024, wnat, 1024, 0, 1024, 1, ks},
                {win, 11264, 1024, 1024, 1024, (bf16_t*)(ws + WS_WKN) + (size_t)l * 3072 * 1024, 1024, 0, 0, 0, ks},
                {win, 11264, 1024, 2048, 2048, (bf16_t*)(ws + WS_WKN) + (size_t)l * 3072 * 1024, 1024, 0, 1024, 0, 1.0f},
                {win, 11264, 1024, 4096, 2048, wnat, 1024, 0, 2048, 3, 1.0f},
                {win, 11264, 1024, 6144, 1024, wnat, 1024, 0, 4096, 3, 1.0f},
                {win, 11264, 1024, 7168, 2048, wnat, 1024, 0, 5120, 5, 1.0f},
                {win, 11264, 1024, 9216, 2048, wnat, 1024, 0, 7168, 3, 1.0f},
                {a.in[I_WRO] + (size_t)l * 2048 * 1024, 1024, 2048, 0, 1024, (bf16_t*)(ws + WS_WY) + (size_t)l * 1024 * 3072, 3072, 0, 0, 0, 1.0f},
                {a.in[I_WCO] + (size_t)l * 1024 * 1024, 1024, 1024, 0, 1024, (bf16_t*)(ws + WS_WY) + (size_t)l * 1024 * 3072, 3072, 2048, 0, 0, 1.0f},
                {a.in[I_WO] + (size_t)l * 1024 * 1024, 1024, 1024, 0, 1024, (bf16_t*)(ws + WS_WO) + (size_t)l * 1024 * 1024, 1024, 0, 0, 0, 1.0f},
                {a.in[I_WFI] + (size_t)l * 1024 * 5632, 5632, 1024, 0, 5632, (bf16_t*)(ws + WS_WFI) + (size_t)l * 5632 * 1024, 1024, 0, 0, 2, 1.0f},
                {a.in[I_WFO] + (size_t)l * DFF * 1024, 1024, DFF, 0, 1024, (bf16_t*)(ws + WS_WFO) + (size_t)l * 1024 * DFF, DFF, 0, 0, 0, 1.0f},
            };
#pragma unroll
            for (int j = 0; j < 13; ++j) convert_job(jobs[j], tl);
        }
    }
    grid.sync();
    volatile LAS unsigned* xst = (volatile LAS unsigned*)(lds + 131072);
    if (tid == 0) { xst[0] = 0u; xst[1] = 0u; }
    __syncthreads();
    const XcdBarrier xb = xcd_barrier_post((unsigned*)(ws + WS_BAR), xst);

    {
        float* red = (float*)lds_raw;
        for (int blk = cid; blk < 192; blk += G) {
            const int l = blk / 96, n0 = (blk % 96) * 64, ksl = tid >> 6, col = tid & 63;
            const float* w = a.in[I_ADAW] + (size_t)l * 1024 * 6144 + n0 + col;
            float accv[33];
#pragma unroll
            for (int b = 0; b < 33; ++b) accv[b] = 0.f;
#pragma unroll 1
            for (int k = ksl * 128; k < ksl * 128 + 128; k += 8) {
                float wv[8];
#pragma unroll
                for (int i = 0; i < 8; ++i) wv[i] = w[(size_t)(k + i) * 6144];
#pragma unroll
                for (int b = 0; b < 33; ++b) { const f32x4 s0 = *(const GAS f32x4*)(sc + b * 1024 + k), s1 = *(const GAS f32x4*)(sc + b * 1024 + k + 4);
                    accv[b] += ((s0[0] * wv[0] + s0[1] * wv[1]) + (s0[2] * wv[2] + s0[3] * wv[3])) + ((s1[0] * wv[4] + s1[1] * wv[5]) + (s1[2] * wv[6] + s1[3] * wv[7])); } }
#pragma unroll
            for (int b = 0; b < 33; ++b) red[(ksl * 33 + b) * 64 + col] = accv[b];
            __syncthreads();
            for (int i = tid; i < 33 * 64; i += 512) { float s = a.in[I_ADAB][l * 6144 + n0 + (i & 63)];
#pragma unroll
                for (int k8 = 0; k8 < 8; ++k8) s += red[k8 * 33 * 64 + i];
                mod_all[((size_t)l * 33 + (i >> 6)) * 6144 + n0 + (i & 63)] = s; }
            __syncthreads();
        }
    }
    { xcd_barrier(xb); if (DUPM & (1 << 11)) xcd_barrier(xb); }

#define P_hb ((bf16_t*)(lw(ws) + WS_H))
#define P_qb ((bf16_t*)(lw(ws) + WS_Q))
#define P_kb ((bf16_t*)(lw(ws) + WS_K))
#define P_ktb ((bf16_t*)(lw(ws) + WS_KT))
#define P_cktb ((bf16_t*)(lw(ws) + WS_CKT))
#define P_sgb ((bf16_t*)(lw(ws) + WS_SG))
#define P_convb ((bf16_t*)(lw(ws) + WS_CONV))
#define P_gatesb ((bf16_t*)(lw(ws) + WS_GATES))
#define P_abuf ((bf16_t*)(lw(ws) + WS_ABUF))
#define P_bbuf ((bf16_t*)(lw(ws) + WS_BBUF))
#define P_cbb ((bf16_t*)(lw(ws) + WS_CBB))
#define P_ob ((bf16_t*)(lw(ws) + WS_O))
#define P_yb ((bf16_t*)(lw(ws) + WS_Y))
#define P_mrgb ((bf16_t*)(lw(ws) + WS_MRG))
#define P_h2b ((bf16_t*)(lw(ws) + WS_H2))
#define P_ub ((bf16_t*)(lw(ws) + WS_U))
#define P_xc ((float*)(lw(ws) + WS_XC))
#define P_cosT ((const float*)(lw(ws) + WS_ROPE))
#define P_sinT ((const float*)(lw(ws) + WS_ROPE + 8192))
#define P_cosT2 ((const float*)(lw(ws) + WS_ROPE + 16384))
#define P_sinT2 ((const float*)(lw(ws) + WS_ROPE + 24576))
#define P_mod ((const float*)(lw(ws) + WS_MOD) + (size_t)l * 33 * 6144)
#define P_l2g ((const float*)(lw(ws) + WS_L2G) + l * 16)
#define P_wnat ((const bf16_t*)(lw(ws) + WS_WNAT) + (size_t)l * NNAT * 1024)
#define P_wkn ((const bf16_t*)(lw(ws) + WS_WKN) + (size_t)l * 3072 * 1024)
#define P_wy ((const bf16_t*)(lw(ws) + WS_WY) + (size_t)l * 1024 * 3072)
#define P_wo ((const bf16_t*)(lw(ws) + WS_WO) + (size_t)l * 1024 * 1024)
#define P_wfi ((const bf16_t*)(lw(ws) + WS_WFI) + (size_t)l * 5632 * 1024)
#define P_wfo ((const bf16_t*)(lw(ws) + WS_WFO) + (size_t)l * 1024 * DFF)
#define AIN(i) ((const float*)lw((unsigned char*)a.in[i]))
#define P_nmw (AIN(I_NMW) + l * 1024)
#define P_nfw (AIN(I_NFW) + l * 1024)
#define P_convw (AIN(I_CONVW) + (size_t)l * 3 * 1024)
#define AOUT ((float*)lw((unsigned char*)a.out))

    bool e1_pending = true;
    for (int l = 0; l < 2; ++l) {
        for (int g = -1; g < NGROUP; ++g) {
            const int ctx = g < 0;
            const int nrows = ctx ? MC : MG, nrt = nrows / 256, nch = ctx ? 1 : 8, b0 = ctx ? 0 : g * GB;
            const bool full = !(ctx && l == 1);
            #define P_xin0 (ctx ? (l == 0 ? AIN(I_CTX) : P_xc) : ((l == 0 ? AIN(I_X) : AOUT) + (size_t)g * MG * 1024))
#define P_xres (ctx ? P_xc : AOUT + (size_t)g * MG * 1024)

            if (e1_pending) { e1_phase(a, ws, l, g); { xcd_barrier(xb); if (DUPM & (1 << 11)) xcd_barrier(xb); } }
            e1_pending = true;
            REP(1) {
            if (full) {
                Sched2D S; S.o.init(nrt, NNAT / 256, G, cid); S.A = (const char*)P_hb; S.B = (const char*)P_wnat; S.sa = S.sb = (size_t)256 * 1024 * 2;
                EpiNat E; E.mid_t = -1; E.q = P_qb; E.sg = P_sgb; E.abuf = P_abuf; E.kft = ctx ? P_cktb : P_ktb; E.cosT = P_cosT; E.sinT = P_sinT; E.l2g = P_l2g; E.nch = nch; E.rope = !ctx;
                if (PHM & (1 << 0)) pg8::gemm_phase(lds, 1024, 1024, 1024, S, E);
            }
            {
                if (full) {
                    Sched2D S; S.o.init(8, nrt, G, cid); S.A = (const char*)(P_wkn + (size_t)1024 * 1024); S.B = (const char*)P_hb; S.sa = S.sb = (size_t)256 * 1024 * 2;
                    EpiVT E; E.mid_t = -1; E.bbuf = ctx ? P_cbb : P_bbuf; E.nch = nch;
                    if (PHM & (1 << 1)) pg8::gemm_phase(lds, 1024, 1024, 1024, S, E);
                } else {
                Sched2D S; S.o.init(12, nrt, G, cid); S.A = (const char*)P_wkn; S.B = (const char*)P_hb; S.sa = S.sb = (size_t)256 * 1024 * 2;
                EpiKV E; E.mid_t = -1; E.kt.kft = ctx ? P_cktb : P_ktb; E.kt.kbt = E.kt.kft + (size_t)64 * KTROWS * 256; E.kt.cosT = P_cosT; E.kt.sinT = P_sinT; E.kt.cosT2 = P_cosT2; E.kt.sinT2 = P_sinT2; E.kt.l2g = P_l2g; E.kt.rope = !ctx;
                E.vt.bbuf = ctx ? P_cbb : P_bbuf; E.vt.nch = nch;
                if (PHM & (1 << 1)) pg8::gemm_phase(lds, 1024, 1024, 1024, S, E);
                }
            }
            { xcd_barrier(xb); if (DUPM & (1 << 11)) xcd_barrier(xb); } }
            if (!full) continue;
            REP(2) {
                const int half = ctx ? 0 : G / 2;
                if (cid >= half) {
                    SchedSlots S; S.G = G - half; S.c = cid - half; S.nslots = nrt * 8; S.nch = nch; S.mode = 0; S.A = (const char*)P_abuf; S.B = (const char*)P_kb;
                    EpiScores E; E.mid_t = -1; E.abuf = P_abuf; E.l2g = P_l2g;
                    int k128 = 128; asm volatile("" : "+s"(k128));
                    if (PHM & (1 << 3)) pg8::gemm_phase(lds, 512, 1024, k128, S, E);
                    if (rep_ == 0) conv_phase(P_sgb, P_convw, nrows, ctx ? 255 : 2047, half, G - half, P_sgb + 2048, XLD);
                    else if (DUPM & (1 << 12)) conv_phase(P_sgb, P_convw, nrows, ctx ? 255 : 2047, half, G - half, P_hb, 1024);
                } else {
                    SchedChain S; S.G = half; S.c = cid; S.b0 = b0; S.cbb = (const char*)P_cbb; S.ckt = (const char*)P_cktb; S.bbuf = (const char*)P_bbuf; S.kt = (const char*)P_ktb; S.l2g = P_l2g;
                    EpiChain E; E.mid_t = -1; E.bbuf = P_bbuf;
                    if (PHM & (1 << 4)) pg8::gemm_phase(lds, 512, 256, 256, S, E);
                }
            { xcd_barrier(xb); if (DUPM & (1 << 11)) xcd_barrier(xb); } }
            REP(3) {
                SchedSlots S; S.G = G; S.c = cid; S.nslots = nrt * 8; S.nch = nch; S.mode = 1; S.A = (const char*)P_abuf; S.B = (const char*)(ctx ? P_cbb : P_bbuf);
                EpiO E; E.mid_t = -1; E.xb = P_sgb; E.xl = lds + 131072 + 256; E.ob = rep_ == 0 ? P_sgb : P_hb; E.opitch = rep_ == 0 ? XLD : 2048;
                if (PHM & (1 << 5)) pg8::gemm_phase(lds, 512, 512, ctx ? 256 : 512, S, E);
            { xcd_barrier(xb); if (DUPM & (1 << 11)) xcd_barrier(xb); } }
            REP(5) {
                Sched2D S; S.o.init(nrt, 4, G, cid); S.A = (const char*)P_sgb; S.B = (const char*)P_wy; S.sa = (size_t)256 * XLD * 2; S.sb = (size_t)256 * 3072 * 2;
                EpiMerge E; E.mid_t = 32; E.gates = P_gatesb; E.mrg = P_mrgb;
                if (PHM & (1 << 6)) pg8::gemm_phase(lds, XLD, 3072, 3072, S, E);
            { xcd_barrier(xb); if (DUPM & (1 << 11)) xcd_barrier(xb); } }
            {
                Sched2D S; S.o.init(nrt, 4, G, cid); S.A = (const char*)P_mrgb; S.B = (const char*)P_wo; S.sa = S.sb = (size_t)256 * 1024 * 2;
                EpiRes E; E.mid_t = -1; E.xin = P_xin0; E.xout = P_xres; E.mod = P_mod; E.b0 = b0; E.ctx = ctx; E.which = 2; E.zero = nullptr;
                if (PHM & (1 << 7)) pg8::gemm_phase(lds, 1024, 1024, 1024, S, E);
            }
            { xcd_barrier(xb); if (DUPM & (1 << 11)) xcd_barrier(xb); }
            if (DUPM & (1 << 9)) {
                Sched2D S; S.o.init(nrt, 4, G, cid); S.A = (const char*)P_mrgb; S.B = (const char*)P_wo; S.sa = S.sb = (size_t)256 * 1024 * 2;
                EpiRes E; E.mid_t = -1; E.xin = P_xres; E.xout = P_xres; E.mod = P_mod; E.b0 = b0; E.ctx = ctx; E.which = 2; E.zero = (const float*)(lw(ws) + WS_ZERO);
                pg8::gemm_phase(lds, 1024, 1024, 1024, S, E);
                { xcd_barrier(xb); if (DUPM & (1 << 11)) xcd_barrier(xb); }
            }
            REP(6) { norm_mod_phase(P_xres, nrows, P_nfw, P_mod, b0, ctx, 3, P_h2b);
            { xcd_barrier(xb); if (DUPM & (1 << 11)) xcd_barrier(xb); } }
            REP(7) {
                Sched2D S; S.o.init(nrt, 22, G, cid); S.A = (const char*)P_h2b; S.B = (const char*)P_wfi; S.sa = S.sb = (size_t)256 * 1024 * 2;
                EpiSwiglu E; E.mid_t = -1; E.uo = P_ub;
                if (PHM & (1 << 8)) pg8::gemm_phase(lds, 1024, 1024, 1024, S, E);
            { xcd_barrier(xb); if (DUPM & (1 << 11)) xcd_barrier(xb); } }
            {
                Sched2D S; S.o.init(nrt, 4, G, cid); S.A = (const char*)P_ub; S.B = (const char*)P_wfo; S.sa = S.sb = (size_t)256 * DFF * 2;
                EpiRes E; E.mid_t = -1; E.xin = P_xres; E.xout = P_xres; E.mod = P_mod; E.b0 = b0; E.ctx = ctx; E.which = 5; E.zero = nullptr;
                if (PHM & (1 << 9)) pg8::gemm_phase(lds, DFF, DFF, DFF, S, E);
            }
            { int g2 = g + 1, l2 = l; if (g2 == NGROUP) { g2 = -1; l2 = l + 1; }
              if (l2 < 2) { e1_phase(a, ws, l2, g2); e1_pending = false; } }
            { xcd_barrier(xb); if (DUPM & (1 << 11)) xcd_barrier(xb); }
            if (DUPM & (1 << 10)) {
                Sched2D S; S.o.init(nrt, 4, G, cid); S.A = (const char*)P_ub; S.B = (const char*)P_wfo; S.sa = S.sb = (size_t)256 * DFF * 2;
                EpiRes E; E.mid_t = -1; E.xin = P_xres; E.xout = P_xres; E.mod = P_mod; E.b0 = b0; E.ctx = ctx; E.which = 5; E.zero = (const float*)(lw(ws) + WS_ZERO);
                pg8::gemm_phase(lds, DFF, DFF, DFF, S, E);
                { xcd_barrier(xb); if (DUPM & (1 << 11)) xcd_barrier(xb); }
            }
        }
    }
    final_norm_phase(AOUT, NB * T, AIN(I_FNW));
}

extern "C" void kernel_launch(void* const* d_in, const int* in_sizes, int n_in, void* d_out, int out_size, void* d_ws, size_t ws_size, hipStream_t stream) {
    static int grid = 0;
    if (grid == 0) {
        if (n_in != 17 || ws_size < WS_END) { fprintf(stderr, "kernel_launch: need 17 inputs and %zu bytes of workspace (got %d, %zu)\n", (size_t)WS_END, n_in, ws_size); grid = -1; return; }
        int dev = 0, cus = 0, per_cu = 0;
        hipGetDevice(&dev);
        hipDeviceGetAttribute(&cus, hipDeviceAttributeMultiprocessorCount, dev);
        if (hipFuncSetAttribute((const void*)mega_fwd, hipFuncAttributeMaxDynamicSharedMemorySize, LDS_BYTES) != hipSuccess) { fprintf(stderr, "kernel_launch: hipFuncSetAttribute failed\n"); grid = -1; return; }
        if (hipOccupancyMaxActiveBlocksPerMultiprocessor(&per_cu, (const void*)mega_fwd, 512, LDS_BYTES) != hipSuccess || per_cu < 1) { fprintf(stderr, "kernel_launch: occupancy query says %d\n", per_cu); per_cu = 1; }
        (void)hipGetLastError();
        grid = cus;
    }
    if (grid < 0) return;
    Args a{};
    for (int i = 0; i < 17; ++i) a.in[i] = (const float*)d_in[i];
    a.out = (float*)d_out; a.ws = (unsigned char*)d_ws;
    void* args[] = {&a};
    hipError_t e = hipLaunchCooperativeKernel((const void*)mega_fwd, dim3(grid), dim3(512), args, LDS_BYTES, stream);
    if (e != hipSuccess) fprintf(stderr, "cooperative launch failed: %s (grid %d)\n", hipGetErrorString(e), grid);
}
```
